# Optimizing an MI355X kernel written in HIP

```python
import math
import jax, jax.numpy as jnp
from jax import lax
import numpy as np

D_MODEL = 1024
BATCH = 8
SEQ = 8192
DEPTH = 2

CHUNK = 64
N_META = 16
SSM_HEAD_DIM = 64
SSM_INNER = D_MODEL
SSM_HEADS = SSM_INNER // SSM_HEAD_DIM
SSM_GROUPS = 2
SSM_STATE = 128
SSM_CONV = 4
SSM_CONV_DIM = SSM_INNER + 2 * SSM_GROUPS * SSM_STATE
RWKV_HEAD_DIM = 64
RWKV_DIM = D_MODEL
RWKV_HEADS = RWKV_DIM // RWKV_HEAD_DIM
RWKV_DECAY_LORA = 64
RWKV_AAA_LORA = 64
RWKV_GATE_LORA = 128
RWKV_COLS = 3 * RWKV_DIM + RWKV_DECAY_LORA + RWKV_AAA_LORA + RWKV_GATE_LORA
RWKV_LN_EPS = 64e-5
IN0 = SSM_INNER + SSM_CONV_DIM + SSM_HEADS + RWKV_COLS
MIX0 = SSM_INNER + RWKV_DIM
LRU_DIM = D_MODEL
LRU_BLOCKS = 8
LRU_BLOCK = LRU_DIM // LRU_BLOCKS
LRU_CONV = 4
LRU_C = 8.0
D_FF = 2816
N_EXPERTS = 8
TOP_K = 2
MOE_BLOCK = 128
N_EVEN = (DEPTH + 1) // 2
N_ODD = DEPTH // 2
DEEPNORM_ALPHA = (2 * DEPTH) ** 0.25
DEEPNORM_BETA = (8 * DEPTH) ** -0.25
LN_EPS = 1e-5

kernel_name = 'hybrid_ssd_rwkv7_rglru_moe_deepnorm'


def layer_norm(x, g, b):
    xf = x.astype(jnp.float32)
    mu = jnp.mean(xf, -1, keepdims=True)
    var = jnp.mean(jnp.square(xf - mu), -1, keepdims=True)
    return ((xf - mu) * lax.rsqrt(var + LN_EPS) * g + b).astype(x.dtype)


def causal_dwconv(x, w, b):
    k = w.shape[0]
    y = lax.conv_general_dilated(x, w[:, None, :].astype(x.dtype), (1,), [(k - 1, 0)],
                                 dimension_numbers=('NWC', 'WIO', 'NWC'),
                                 feature_group_count=x.shape[-1])
    return y + b


def swiglu(x, w_gu, w_down):
    g, u = jnp.split(x @ w_gu, 2, axis=-1)
    return (jax.nn.silu(g) * u) @ w_down


def ssd_chunked(x, dt, A, Bm, Cm):
    b, l, g, e, p = x.shape
    n = Bm.shape[-1]
    c, q = l // CHUNK, CHUNK
    xdt = (x * dt[..., None]).reshape(b, c, q, g, e, p)
    Bc = Bm.reshape(b, c, q, g, n)
    Cc = Cm.reshape(b, c, q, g, n)
    acs = jnp.cumsum(jnp.moveaxis((dt * A).reshape(b, c, q, g, e), 2, -1), axis=-1)
    causal = jnp.tril(jnp.ones((q, q), bool))
    decay_in = jnp.exp(jnp.where(causal, acs[..., :, None] - acs[..., None, :], -jnp.inf))
    scores = jnp.einsum('bclgn,bcsgn->bcgls', Cc, Bc)
    y_diag = jnp.einsum('bcgels,bcsgep->bclgep', scores[:, :, :, None] * decay_in, xdt)
    to_end = jnp.moveaxis(jnp.exp(acs[..., -1:] - acs), -1, 2)[..., None]
    states = jnp.einsum('bcsgn,bcsgep->bcgepn', Bc, xdt * to_end)
    chunk_decay = jnp.exp(acs[..., -1])

    def carry_state(h, inp):
        s, d = inp
        return h * d[..., None, None] + s, h

    _, prev = lax.scan(carry_state, jnp.zeros_like(states[:, 0]),
                       (jnp.moveaxis(states, 1, 0), jnp.moveaxis(chunk_decay, 1, 0)))
    prev = jnp.moveaxis(prev, 0, 1)
    y_off = jnp.einsum('bclgn,bcgepn->bclgep', Cc, prev) * jnp.moveaxis(jnp.exp(acs), -1, 2)[..., None]
    return (y_diag + y_off).reshape(b, l, g, e, p)


def ssd_branch(z, xbc, dt_raw, conv_w, conv_b, dt_bias, a_log, d_skip, norm_w):
    b, l, _ = z.shape
    pad = (-l) % CHUNK
    lp = l + pad
    xbc = jax.nn.silu(causal_dwconv(jnp.pad(xbc, ((0, 0), (pad, 0), (0, 0))), conv_w, conv_b))
    xs, bm, cm = jnp.split(xbc.astype(jnp.float32), [SSM_INNER, SSM_INNER + SSM_GROUPS * SSM_STATE], axis=-1)
    valid = (jnp.arange(lp) >= pad).astype(jnp.float32)[None, :, None]
    dt = jax.nn.softplus(jnp.pad(dt_raw.astype(jnp.float32), ((0, 0), (pad, 0), (0, 0))) + dt_bias) * valid
    g, e = SSM_GROUPS, SSM_HEADS // SSM_GROUPS
    xs = xs.reshape(b, lp, g, e, SSM_HEAD_DIM)
    A = -jnp.exp(a_log.astype(jnp.float32)).reshape(g, e)
    y = ssd_chunked(xs, dt.reshape(b, lp, g, e), A,
                    bm.reshape(b, lp, g, SSM_STATE), cm.reshape(b, lp, g, SSM_STATE))
    y = (y + d_skip.reshape(g, e, 1) * xs)[:, pad:].reshape(b, l, g, e * SSM_HEAD_DIM)
    y = y * jax.nn.silu(z.astype(jnp.float32)).reshape(b, l, g, e * SSM_HEAD_DIM)
    y = y * lax.rsqrt(jnp.mean(y * y, -1, keepdims=True) + LN_EPS) * norm_w.reshape(g, -1)
    return y.reshape(b, l, SSM_INNER).astype(z.dtype)


def rwkv7_recurrence(r, decay, k, v, kk, a):
    def step(S, inp):
        r_t, w_t, k_t, v_t, kk_t, a_t = inp
        sa = jnp.einsum('bhvk,bhk->bhv', S, kk_t)
        S = S * w_t[:, :, None, :] - sa[..., None] * (kk_t * a_t)[:, :, None, :] + v_t[..., None] * k_t[:, :, None, :]
        return S, jnp.einsum('bhvk,bhk->bhv', S, r_t)

    b, l, h, n = r.shape
    seq = tuple(jnp.moveaxis(t, 1, 0) for t in (r, decay, k, v, kk, a))
    _, out = lax.scan(step, jnp.zeros((b, h, n, n), jnp.float32), seq)
    return jnp.moveaxis(out, 0, 1)


def rwkv7_branch(cols, shift_mu, w0, w_up, a0, a_up, g_up, k_k, k_a, r_k, lnx_g, lnx_b):
    b, l, _ = cols.shape
    hs = (RWKV_HEADS, RWKV_HEAD_DIM)
    prev = jnp.pad(cols, ((0, 0), (1, 0), (0, 0)))[:, :l]
    mixed = (cols + (prev - cols) * shift_mu).astype(jnp.float32)
    s1, s2, s3 = RWKV_DIM, 2 * RWKV_DIM, 3 * RWKV_DIM
    s4 = s3 + RWKV_DECAY_LORA
    s5 = s4 + RWKV_AAA_LORA
    r, k, v, w_lo, a_lo, g_lo = jnp.split(mixed, [s1, s2, s3, s4, s5], axis=-1)
    w = -jax.nn.softplus(-(w0 + jnp.tanh(w_lo) @ w_up)) - 0.5
    decay = jnp.exp(-jnp.exp(w))
    a = jax.nn.sigmoid(a0 + a_lo @ a_up)
    gate = jax.nn.sigmoid(g_lo) @ g_up
    r, k, v, decay, a = (t.reshape(b, l, *hs) for t in (r, k, v, decay, a))
    kk = k * k_k.reshape(hs)
    kk = kk * lax.rsqrt(jnp.maximum(jnp.sum(kk * kk, -1, keepdims=True), 1e-24))
    k = k * (1.0 + (a - 1.0) * k_a.reshape(hs))
    o = rwkv7_recurrence(r, decay, k, v, kk, a)
    mu = jnp.mean(o, -1, keepdims=True)
    var = jnp.mean(jnp.square(o - mu), -1, keepdims=True)
    o = (o - mu) * lax.rsqrt(var + RWKV_LN_EPS) * lnx_g.reshape(hs) + lnx_b.reshape(hs)
    o = o + jnp.sum(r * k * r_k, -1, keepdims=True) * v
    return (o.reshape(b, l, RWKV_DIM) * gate).astype(cols.dtype)


def ssd_rwkv_mixer(h, w_in, conv_w, conv_b, dt_bias, a_log, d_skip, ssm_norm, shift_mu, w0, w_up,
                   a0, a_up, g_up, k_k, k_a, r_k, lnx_g, lnx_b, w_out):
    proj = h @ w_in
    z, xbc, dt_raw, cols = jnp.split(
        proj, [SSM_INNER, SSM_INNER + SSM_CONV_DIM, SSM_INNER + SSM_CONV_DIM + SSM_HEADS], axis=-1)
    y_a = ssd_branch(z, xbc, dt_raw, conv_w, conv_b, dt_bias, a_log, d_skip, ssm_norm)
    y_b = rwkv7_branch(cols, shift_mu, w0, w_up, a0, a_up, g_up, k_k, k_a, r_k, lnx_g, lnx_b)
    return jnp.concatenate([y_a, y_b], axis=-1) @ w_out


def rglru_block(h, w_in, conv_w, conv_b, gx_w, gx_b, ga_w, ga_b, lam, w_out):
    b, l, _ = h.shape
    gate_branch, xr = jnp.split(h @ w_in, 2, axis=-1)
    xf = causal_dwconv(xr, conv_w, conv_b).astype(jnp.float32)
    xb = xf.reshape(b, l, LRU_BLOCKS, LRU_BLOCK)
    gate_x = jax.nn.sigmoid(jnp.einsum('blhi,hij->blhj', xb, gx_w).reshape(b, l, LRU_DIM) + gx_b)
    gate_a = jax.nn.sigmoid(jnp.einsum('blhi,hij->blhj', xb, ga_w).reshape(b, l, LRU_DIM) + ga_b)
    log_a = -LRU_C * gate_a * jax.nn.softplus(-lam)
    a = jnp.exp(log_a)
    u = jnp.sqrt(-jnp.expm1(2.0 * log_a)) * (gate_x * xf)

    def combine(lhs, rhs):
        a1, b1 = lhs
        a2, b2 = rhs
        return a1 * a2, a2 * b1 + b2

    _, hs = lax.associative_scan(combine, (a, u), axis=1)
    y = hs.astype(h.dtype) * jax.nn.gelu(gate_branch)
    return y @ w_out


def moe_swiglu(x, w_router, w_gu, w_down):
    b, l, d = x.shape
    n_tok = b * l
    n_slot = n_tok * TOP_K
    xt = x.reshape(n_tok, d)
    logits = (xt @ w_router).astype(jnp.float32)
    top_logit, top_idx = lax.top_k(logits, TOP_K)
    top_gate = jax.nn.softmax(top_logit, axis=-1)
    slot_e = top_idx.reshape(n_slot)
    order = jnp.argsort(slot_e, stable=True)
    sorted_e = slot_e[order]
    sorted_tok = order // TOP_K
    sorted_gate = top_gate.reshape(n_slot)[order]
    counts = jnp.bincount(slot_e, length=N_EXPERTS)
    starts = jnp.cumsum(counts) - counts
    padded = (counts + MOE_BLOCK - 1) // MOE_BLOCK * MOE_BLOCK
    padded_end = jnp.cumsum(padded)
    dest = (padded_end - padded)[sorted_e] + jnp.arange(n_slot) - starts[sorted_e]
    n_blocks = -(-(n_slot + N_EXPERTS * (MOE_BLOCK - 1)) // MOE_BLOCK)
    buf = jnp.zeros((n_blocks * MOE_BLOCK, d), x.dtype).at[dest].set(xt[sorted_tok])
    block_e = jnp.minimum(jnp.searchsorted(padded_end, jnp.arange(n_blocks) * MOE_BLOCK, side='right'),
                          N_EXPERTS - 1)

    def expert_block(args):
        xb, e = args
        return swiglu(xb, w_gu[e], w_down[e])

    out = lax.map(expert_block, (buf.reshape(n_blocks, MOE_BLOCK, d), block_e)).reshape(n_blocks * MOE_BLOCK, d)
    y = jnp.zeros((n_tok, d), x.dtype).at[sorted_tok].add(out[dest] * sorted_gate[:, None].astype(x.dtype))
    return y.reshape(b, l, d)


def setup_inputs(seed: int = 0) -> dict:
    key = jax.random.key(seed)
    keys = jax.random.split(key, 64)
    counter = [0]
    f32 = jnp.float32

    def nxt():
        k = keys[counter[0]]
        counter[0] += 1
        return k

    def nrm(shape, scale):
        return jax.random.normal(nxt(), shape, f32) * scale

    def unif(shape, lo, hi):
        return jax.random.uniform(nxt(), shape, f32, lo, hi)

    def gain(shape):
        return 1.0 + nrm(shape, 0.05)

    NE, NO = N_EVEN, N_ODD
    dt0 = jnp.exp(unif((NE, SSM_HEADS), math.log(1e-3), math.log(1e-1)))
    a_root = unif((NO, LRU_DIM), 0.9, 0.999) ** (1.0 / LRU_C)
    return {
        'x': nrm((BATCH, SEQ, D_MODEL), 1.0),
        'meta': nrm((N_META, D_MODEL), 1.0),
        'ev_w_in': nrm((NE, D_MODEL, IN0), D_MODEL ** -0.5),
        'ev_conv_w': nrm((NE, SSM_CONV, SSM_CONV_DIM), 0.5),
        'ev_conv_b': nrm((NE, SSM_CONV_DIM), 0.1),
        'ev_dt_bias': dt0 + jnp.log(-jnp.expm1(-dt0)),
        'ev_a_log': jnp.log(unif((NE, SSM_HEADS), 1.0, 16.0)),
        'ev_d_skip': 1.0 + nrm((NE, SSM_HEADS), 0.1),
        'ev_ssm_norm': gain((NE, SSM_INNER)),
        'ev_shift_mu': unif((NE, RWKV_COLS), 0.0, 1.0),
        'ev_w0': unif((NE, RWKV_DIM), -6.0, -1.0),
        'ev_w_up': nrm((NE, RWKV_DECAY_LORA, RWKV_DIM), 0.5 * RWKV_DECAY_LORA ** -0.5),
        'ev_a0': nrm((NE, RWKV_DIM), 0.5),
        'ev_a_up': nrm((NE, RWKV_AAA_LORA, RWKV_DIM), 0.5 * RWKV_AAA_LORA ** -0.5),
        'ev_g_up': nrm((NE, RWKV_GATE_LORA, RWKV_DIM), RWKV_GATE_LORA ** -0.5),
        'ev_k_k': 0.85 + nrm((NE, RWKV_DIM), 0.05),
        'ev_k_a': gain((NE, RWKV_DIM)),
        'ev_r_k': nrm((NE, RWKV_HEADS, RWKV_HEAD_DIM), 0.1),
        'ev_lnx_g': gain((NE, RWKV_DIM)),
        'ev_lnx_b': nrm((NE, RWKV_DIM), 0.02),
        'ev_w_out': nrm((NE, MIX0, D_MODEL), DEEPNORM_BETA * MIX0 ** -0.5),
        'ev_ln1_g': gain((NE, D_MODEL)),
        'ev_ln1_b': nrm((NE, D_MODEL), 0.02),
        'ev_ffn_w_gu': nrm((NE, D_MODEL, 2 * D_FF), D_MODEL ** -0.5),
        'ev_ffn_w_down': nrm((NE, D_FF, D_MODEL), DEEPNORM_BETA * D_FF ** -0.5),
        'ev_ln2_g': gain((NE, D_MODEL)),
        'ev_ln2_b': nrm((NE, D_MODEL), 0.02),
        'od_w_in': nrm((NO, D_MODEL, 2 * LRU_DIM), D_MODEL ** -0.5),
        'od_conv_w': nrm((NO, LRU_CONV, LRU_DIM), 0.5),
        'od_conv_b': nrm((NO, LRU_DIM), 0.1),
        'od_gx_w': nrm((NO, LRU_BLOCKS, LRU_BLOCK, LRU_BLOCK), LRU_BLOCK ** -0.5),
        'od_gx_b': nrm((NO, LRU_DIM), 0.1),
        'od_ga_w': nrm((NO, LRU_BLOCKS, LRU_BLOCK, LRU_BLOCK), LRU_BLOCK ** -0.5),
        'od_ga_b': nrm((NO, LRU_DIM), 0.1),
        'od_lambda': jnp.log(a_root) - jnp.log1p(-a_root),
        'od_w_out': nrm((NO, LRU_DIM, D_MODEL), DEEPNORM_BETA * LRU_DIM ** -0.5),
        'od_ln1_g': gain((NO, D_MODEL)),
        'od_ln1_b': nrm((NO, D_MODEL), 0.02),
        'od_router': nrm((NO, D_MODEL, N_EXPERTS), D_MODEL ** -0.5),
        'od_exp_w_gu': nrm((NO, N_EXPERTS, D_MODEL, 2 * D_FF), D_MODEL ** -0.5),
        'od_exp_w_down': nrm((NO, N_EXPERTS, D_FF, D_MODEL), DEEPNORM_BETA * D_FF ** -0.5),
        'od_ln2_g': gain((NO, D_MODEL)),
        'od_ln2_b': nrm((NO, D_MODEL), 0.02),
    }


def reference(x, meta, ev_w_in, ev_conv_w, ev_conv_b, ev_dt_bias, ev_a_log, ev_d_skip, ev_ssm_norm,
              ev_shift_mu, ev_w0, ev_w_up, ev_a0, ev_a_up, ev_g_up, ev_k_k, ev_k_a, ev_r_k, ev_lnx_g,
              ev_lnx_b, ev_w_out, ev_ln1_g, ev_ln1_b, ev_ffn_w_gu, ev_ffn_w_down, ev_ln2_g, ev_ln2_b,
              od_w_in, od_conv_w, od_conv_b, od_gx_w, od_gx_b, od_ga_w, od_ga_b, od_lambda, od_w_out,
              od_ln1_g, od_ln1_b, od_router, od_exp_w_gu, od_exp_w_down, od_ln2_g, od_ln2_b):
    b = x.shape[0]
    h = jnp.concatenate([jnp.broadcast_to(meta.astype(x.dtype)[None], (b, N_META, D_MODEL)), x], axis=1)
    for layer in range(DEPTH):
        i = layer // 2
        if layer % 2 == 0:
            mix = ssd_rwkv_mixer(h, ev_w_in[i], ev_conv_w[i], ev_conv_b[i], ev_dt_bias[i], ev_a_log[i],
                                 ev_d_skip[i], ev_ssm_norm[i], ev_shift_mu[i], ev_w0[i], ev_w_up[i],
                                 ev_a0[i], ev_a_up[i], ev_g_up[i], ev_k_k[i], ev_k_a[i], ev_r_k[i],
                                 ev_lnx_g[i], ev_lnx_b[i], ev_w_out[i])
            h = layer_norm(DEEPNORM_ALPHA * h + mix, ev_ln1_g[i], ev_ln1_b[i])
            h = layer_norm(DEEPNORM_ALPHA * h + swiglu(h, ev_ffn_w_gu[i], ev_ffn_w_down[i]),
                           ev_ln2_g[i], ev_ln2_b[i])
        else:
            mix = rglru_block(h, od_w_in[i], od_conv_w[i], od_conv_b[i], od_gx_w[i], od_gx_b[i],
                              od_ga_w[i], od_ga_b[i], od_lambda[i], od_w_out[i])
            h = layer_norm(DEEPNORM_ALPHA * h + mix, od_ln1_g[i], od_ln1_b[i])
            h = layer_norm(DEEPNORM_ALPHA * h + moe_swiglu(h, od_router[i], od_exp_w_gu[i], od_exp_w_down[i]),
                           od_ln2_g[i], od_ln2_b[i])
    return h[:, N_META:]
```

```cpp
#include <hip/hip_runtime.h>
#include <cstdio>
#include <cstdint>

#define GAS __attribute__((address_space(1)))
#define LAS __attribute__((address_space(3)))
typedef unsigned short bf16;
typedef unsigned v4u __attribute__((ext_vector_type(4)));
typedef unsigned v2u __attribute__((ext_vector_type(2)));
typedef float f32x4 __attribute__((ext_vector_type(4)));
typedef float f32x2 __attribute__((ext_vector_type(2)));
typedef short bf16x8 __attribute__((ext_vector_type(8)));
typedef GAS unsigned gu32;
#define RLX_AGENT __ATOMIC_RELAXED, __HIP_MEMORY_SCOPE_AGENT
#define LDS_WAIT() asm volatile("s_waitcnt lgkmcnt(0)" ::: "memory")
#define VM_WAIT() asm volatile("s_waitcnt vmcnt(0)" ::: "memory")
__device__ __forceinline__ unsigned f2bf(float f) { unsigned u = __builtin_bit_cast(unsigned, f); return (u + 0x7fffu + ((u >> 16) & 1u)) >> 16; }
__device__ __forceinline__ unsigned pk2(float lo, float hi) { return f2bf(lo) | (f2bf(hi) << 16); }
typedef __bf16 bf16x2_t __attribute__((ext_vector_type(2)));
__device__ __forceinline__ unsigned cvt_pk_bf16(float lo, float hi) { const f32x2 v = {lo, hi}; return __builtin_bit_cast(unsigned, __builtin_convertvector(v, bf16x2_t)); }
__device__ __forceinline__ float bflo(unsigned w) { return __builtin_bit_cast(float, w << 16); }
__device__ __forceinline__ float bfhi(unsigned w) { return __builtin_bit_cast(float, w & 0xffff0000u); }
__device__ __forceinline__ float bf2f(bf16 h) { return __builtin_bit_cast(float, (unsigned)h << 16); }
__device__ __forceinline__ float fast_rcp(float x) { return __builtin_amdgcn_rcpf(x); }
__device__ __forceinline__ float fast_exp(float x) { return __builtin_amdgcn_exp2f(x * 1.4426950408889634f); }
__device__ __forceinline__ float sigmoidf_(float x) { return fast_rcp(1.0f + fast_exp(-x)); }
__device__ __forceinline__ float siluf_(float x) { return x * sigmoidf_(x); }
__device__ __forceinline__ float softplusf_(float x) { return x > 20.f ? x : log1pf(fast_exp(x)); }
#define DPPF(x, ctrl) __builtin_bit_cast(float, __builtin_amdgcn_update_dpp(0, __builtin_bit_cast(int, (x)), (ctrl), 0xF, 0xF, false))
__device__ __forceinline__ float wave_sum(float v) {
    v += DPPF(v, 0xB1); v += DPPF(v, 0x4E); v += DPPF(v, 0x141); v += DPPF(v, 0x140);
    const int b = __builtin_bit_cast(int, v);
    return (__builtin_bit_cast(float, __builtin_amdgcn_readlane(b, 0)) + __builtin_bit_cast(float, __builtin_amdgcn_readlane(b, 16))) + (__builtin_bit_cast(float, __builtin_amdgcn_readlane(b, 32)) + __builtin_bit_cast(float, __builtin_amdgcn_readlane(b, 48)));
}
__device__ __forceinline__ float wave_max(float v) {
    v = fmaxf(v, DPPF(v, 0xB1)); v = fmaxf(v, DPPF(v, 0x4E)); v = fmaxf(v, DPPF(v, 0x141)); v = fmaxf(v, DPPF(v, 0x140));
    const int b = __builtin_bit_cast(int, v);
    return fmaxf(fmaxf(__builtin_bit_cast(float, __builtin_amdgcn_readlane(b, 0)), __builtin_bit_cast(float, __builtin_amdgcn_readlane(b, 16))), fmaxf(__builtin_bit_cast(float, __builtin_amdgcn_readlane(b, 32)), __builtin_bit_cast(float, __builtin_amdgcn_readlane(b, 48))));
}

namespace pg8 {
#define PG8_LAS __attribute__((address_space(3)))
typedef unsigned short bf16_t;
typedef short bf16x8 __attribute__((ext_vector_type(8)));
typedef float f32x4 __attribute__((ext_vector_type(4)));
typedef unsigned u32x4 __attribute__((ext_vector_type(4)));
constexpr int BM = 256, BK = 64, HALF = 128, HTB = HALF * BK * 2  , STAGE_BYTES = 8 * HTB, NXCD = 8, WGM = 8;

__host__ __device__ __forceinline__ int lds_byte(int r, int c) { const int st = (r >> 4) * 2 + (c >> 5), rr = r & 15, cc = c & 31, ob = rr * 64 + cc * 2; return st * 1024 + (ob ^ (((ob >> 9) & 1) << 5)); }
__host__ __device__ __forceinline__ void stage_rc(int b, int& R, int& C) { const int st = b / 1024, sb = b % 1024, swz = sb ^ (((sb >> 9) & 1) << 5); R = (st >> 1) * 16 + swz / 64; C = (st & 1) * 32 + (swz % 64) / 2; }
__host__ __device__ __forceinline__ int perm32(int rho) { const int n = rho >> 4, i = rho & 15; return 8 * (i >> 2) + 4 * n + (i & 3); }

struct Unit { int pm, pn, pb, pe; };
struct Gemm { const bf16_t* A; const bf16_t* Bt; int lda, K; };

struct StaticOrder {
    int nM, nN, nwg, G, c;
    __host__ __device__ void init(int nM_, int nN_, int G_, int c_) { nM = nM_; nN = nN_; nwg = nM * nN; G = G_; c = c_; }
    __host__ __device__ bool next(int i, Unit& u) const {
        const long L = (long)i * G + c; if (L >= nwg) return false;
        int wgid = (int)L; { const int q = nwg / NXCD, r = nwg % NXCD, xcd = wgid % NXCD, off = wgid / NXCD; wgid = (xcd < r ? xcd * (q + 1) : r * (q + 1) + (xcd - r) * q) + off; }
        const int nig = WGM * nN, gid = wgid / nig, fm = gid * WGM, gsz = (nM - fm) < WGM ? (nM - fm) : WGM;
        u.pm = fm + ((wgid % nig) % gsz); u.pn = (wgid % nig) / gsz; u.pb = u.pn; u.pe = 0; return true;
    }
    __device__ __forceinline__ void a_ready(const Unit&) const {}
    __device__ __forceinline__ void done(const Unit&) const {}
};
typedef int i32x4 __attribute__((ext_vector_type(4)));
template <bool I8> struct AccSel { typedef f32x4 T; };
template <> struct AccSel<true> { typedef i32x4 T; };
template <bool I8> __device__ __forceinline__ typename AccSel<I8>::T mma16(bf16x8 b, bf16x8 a, typename AccSel<I8>::T c) {
    if constexpr (I8) return __builtin_amdgcn_mfma_i32_16x16x64_i8(__builtin_bit_cast(i32x4, b), __builtin_bit_cast(i32x4, a), c, 0, 0, 0);
    else return __builtin_amdgcn_mfma_f32_16x16x32_bf16(b, a, c, 0, 0, 0);
}
template <class Epi, class Sched, bool ALIGN_EPI = false, bool SP2 = false, bool I8 = false>
__device__ __forceinline__ void gemm_phase(PG8_LAS unsigned char* lds, const Gemm g, const Sched& S, const Epi& E) {
    const int tid = threadIdx.x, wid = __builtin_amdgcn_readfirstlane(tid >> 6), lane = tid & 63, wr = wid >> 2, wc = wid & 3, fr = lane & 15, fq = lane >> 4;
    const int K = g.K, nt = K / BK;
    unsigned voffA[2], voffB[2];
#pragma unroll
    for (int i = 0; i < 2; ++i) { int R, C; stage_rc(tid * 16 + i * 8192, R, C); const int Rb = Epi::PERM ? ((R & ~31) + perm32(R & 31)) : R;
        voffA[i] = (unsigned)(R * g.lda + C) * 2u; voffB[i] = (unsigned)(Rb * K + C) * 2u; }
    const size_t kstep = (size_t)(BK * 2);
    const size_t hstepA = (size_t)HALF * g.lda * 2, hstepB = (size_t)HALF * K * 2;
    const size_t tstepA = 2 * hstepA, tstepB = 2 * hstepB;
    const unsigned ldsw = (unsigned)wid * 1024u;
    const int aoff = lds_byte(wr * 64 + fr, fq * 8), boff = lds_byte(wc * 32 + fr, fq * 8);
#define PG8_SA(b, h) (((b) * 2 + (h)) * HTB)
#define PG8_SB(b, h) ((4 + (b) * 2 + (h)) * HTB)
#define PG8_STAGE(bufoff, gbase, voff) do { _Pragma("unroll") for (int _i = 0; _i < 2; ++_i) \
        __builtin_amdgcn_global_load_lds((const unsigned*)((const char*)(gbase) + (voff)[_i]), (PG8_LAS unsigned*)(lds + (bufoff) + ldsw + _i * 8192), 16, 0, 0); } while (0)
#define PG8_LDA(dst, b, h) do { _Pragma("unroll") for (int m = 0; m < 4; ++m) _Pragma("unroll") for (int k = 0; k < 2; ++k) dst[m][k] = *(const PG8_LAS bf16x8*)(lds + PG8_SA(b, h) + aoff + m * 2048 + k * 1024); } while (0)
#define PG8_LDB(dst, b, h) do { _Pragma("unroll") for (int n = 0; n < 2; ++n) _Pragma("unroll") for (int k = 0; k < 2; ++k) dst[n][k] = *(const PG8_LAS bf16x8*)(lds + PG8_SB(b, h) + boff + n * 2048 + k * 1024); } while (0)
#define PG8_MMA(ai, bj, At, Bt) do { __builtin_amdgcn_s_setprio(1); _Pragma("unroll") for (int m = 0; m < 4; ++m) _Pragma("unroll") for (int n = 0; n < 2; ++n) _Pragma("unroll") for (int k = 0; k < 2; ++k) \
        acc[ai][bj][m][n] = mma16<I8>(Bt[n][k], At[m][k], acc[ai][bj][m][n]); __builtin_amdgcn_s_setprio(0); } while (0)
#define PG8_WAIT_V(n) asm volatile("s_waitcnt vmcnt(" #n ")" ::: "memory")
#define PG8_WAIT_L(n) asm volatile("s_waitcnt lgkmcnt(" #n ")" ::: "memory")
#define PG8_BAR __builtin_amdgcn_s_barrier()
#define PG8_SCHED __builtin_amdgcn_sched_barrier(0)
    Unit cur, nxt; int ui = 0;
    if (!S.next(0, cur)) return;
    typedef typename AccSel<I8>::T AccT;
    AccT acc[2][2][4][2];
#pragma unroll
    for (int a = 0; a < 2; ++a)
#pragma unroll
        for (int b = 0; b < 2; ++b)
#pragma unroll
            for (int m = 0; m < 4; ++m)
#pragma unroll
                for (int n = 0; n < 2; ++n) acc[a][b][m][n] = (AccT){0, 0, 0, 0};
    bf16x8 At[4][2], B0[2][2], B1[2][2];
    const char* cA = (const char*)g.A + (size_t)cur.pm * tstepA; const char* cB = (const char*)g.Bt + (size_t)cur.pb * tstepB;
    Epi Em = E;
    if constexpr (Epi::PREFETCH) Em.prefetch(cur, wr, wc, fr, fq);
    S.a_ready(cur);
    if constexpr (SP2) {
        PG8_STAGE(PG8_SB(0, 0), cB, voffB); PG8_STAGE(PG8_SB(0, 1), cB + hstepB, voffB); PG8_STAGE(PG8_SA(0, 0), cA, voffA); PG8_STAGE(PG8_SA(0, 1), cA + hstepA, voffA);
        if (wr == 1) PG8_BAR;
        PG8_WAIT_V(2); PG8_BAR;
        PG8_STAGE(PG8_SB(1, 0), cB + kstep, voffB); PG8_STAGE(PG8_SA(1, 0), cA + kstep, voffA); PG8_STAGE(PG8_SB(1, 1), cB + hstepB + kstep, voffB);
        PG8_WAIT_V(6); PG8_BAR;
    } else {
        PG8_STAGE(PG8_SB(0, 0), cB, voffB); PG8_STAGE(PG8_SA(0, 0), cA, voffA); PG8_STAGE(PG8_SB(0, 1), cB + hstepB, voffB); PG8_STAGE(PG8_SA(0, 1), cA + hstepA, voffA);
        if (wr == 1) PG8_BAR;
        PG8_WAIT_V(4); PG8_BAR;
        PG8_STAGE(PG8_SB(1, 0), cB + kstep, voffB); PG8_STAGE(PG8_SA(1, 0), cA + kstep, voffA); PG8_STAGE(PG8_SB(1, 1), cB + hstepB + kstep, voffB);
        PG8_WAIT_V(6); PG8_BAR;
    }
    for (;;) {
        const bool has_next = S.next(ui + 1, nxt);
        const char* nA = has_next ? (const char*)g.A + (size_t)nxt.pm * tstepA : cA; const char* nB = has_next ? (const char*)g.Bt + (size_t)nxt.pb * tstepB : cB;
        for (int t = 0; t < nt; t += 2) {
            const bool last = (t == nt - 2);
            const char* a1 = cA + (size_t)(t + 1) * kstep;
            const char* a2 = last ? nA : cA + (size_t)(t + 2) * kstep; const char* b2 = last ? nB : cB + (size_t)(t + 2) * kstep;
            const char* a3 = a2 + kstep; const char* b3 = b2 + kstep;
            if (last && has_next) S.a_ready(nxt);
            if constexpr (SP2) {
            PG8_LDB(B0, 0, 0); PG8_LDB(B1, 0, 1); PG8_SCHED; PG8_LDA(At, 0, 0); PG8_STAGE(PG8_SA(1, 1), a1 + hstepA, voffA);
            PG8_WAIT_V(8); PG8_WAIT_L(0); PG8_BAR; PG8_MMA(0, 0, At, B0); PG8_MMA(0, 1, At, B1); PG8_BAR; PG8_SCHED;
            PG8_LDA(At, 0, 1); PG8_STAGE(PG8_SB(0, 0), b2, voffB); PG8_STAGE(PG8_SB(0, 1), b2 + hstepB, voffB); PG8_STAGE(PG8_SA(0, 0), a2, voffA);
            PG8_WAIT_V(8); PG8_WAIT_L(0); PG8_BAR; PG8_MMA(1, 0, At, B0); PG8_MMA(1, 1, At, B1); PG8_BAR; PG8_SCHED;
            PG8_LDB(B0, 1, 0); PG8_LDB(B1, 1, 1); PG8_SCHED; PG8_LDA(At, 1, 0); PG8_STAGE(PG8_SA(0, 1), a2 + hstepA, voffA);
            PG8_WAIT_V(8); PG8_WAIT_L(0); PG8_BAR; PG8_MMA(0, 0, At, B0); PG8_MMA(0, 1, At, B1); PG8_BAR; PG8_SCHED;
            PG8_LDA(At, 1, 1); PG8_STAGE(PG8_SB(1, 0), b3, voffB); PG8_STAGE(PG8_SB(1, 1), b3 + hstepB, voffB); PG8_STAGE(PG8_SA(1, 0), a3, voffA);
            PG8_WAIT_V(8); PG8_WAIT_L(0); PG8_BAR; PG8_MMA(1, 0, At, B0); PG8_MMA(1, 1, At, B1); PG8_BAR; PG8_SCHED;
            } else {
            PG8_LDB(B0, 0, 0); PG8_SCHED; PG8_LDA(At, 0, 0); PG8_STAGE(PG8_SA(1, 1), a1 + hstepA, voffA);
            PG8_WAIT_L(8); PG8_BAR; PG8_WAIT_L(0); PG8_MMA(0, 0, At, B0); PG8_BAR; PG8_SCHED;
            PG8_LDB(B1, 0, 1); PG8_STAGE(PG8_SB(0, 0), b2, voffB);
            PG8_BAR; PG8_WAIT_L(0); PG8_MMA(0, 1, At, B1); PG8_BAR;
            PG8_LDA(At, 0, 1); PG8_STAGE(PG8_SA(0, 0), a2, voffA);
            PG8_BAR; PG8_WAIT_L(0); PG8_MMA(1, 0, At, B0); PG8_BAR; PG8_SCHED;
            PG8_STAGE(PG8_SB(0, 1), b2 + hstepB, voffB);
            PG8_WAIT_V(6); PG8_BAR; PG8_MMA(1, 1, At, B1); PG8_BAR;
            PG8_LDB(B0, 1, 0); PG8_SCHED; PG8_LDA(At, 1, 0); PG8_STAGE(PG8_SA(0, 1), a2 + hstepA, voffA);
            PG8_WAIT_L(8); PG8_BAR; PG8_WAIT_L(0); PG8_MMA(0, 0, At, B0); PG8_BAR; PG8_SCHED;
            PG8_LDB(B1, 1, 1); PG8_STAGE(PG8_SB(1, 0), b3, voffB);
            PG8_BAR; PG8_WAIT_L(0); PG8_MMA(0, 1, At, B1); PG8_BAR;
            PG8_LDA(At, 1, 1); PG8_STAGE(PG8_SA(1, 0), a3, voffA);
            PG8_BAR; PG8_WAIT_L(0); PG8_MMA(1, 0, At, B0); PG8_BAR; PG8_SCHED;
            PG8_STAGE(PG8_SB(1, 1), b3 + hstepB, voffB);
            PG8_WAIT_V(6); PG8_BAR; PG8_MMA(1, 1, At, B1); PG8_BAR;
            }
        }
        if constexpr (ALIGN_EPI) { if (wr == 0) PG8_BAR; }
        if constexpr (!Epi::AFTER_DRAIN) { Em(acc, cur, wr, wc, fr, fq); S.done(cur); }
        if (!has_next) break;
#pragma unroll
        for (int a = 0; a < 2; ++a)
#pragma unroll
            for (int b = 0; b < 2; ++b)
#pragma unroll
                for (int m = 0; m < 4; ++m)
#pragma unroll
                    for (int n = 0; n < 2; ++n) acc[a][b][m][n] = (AccT){0, 0, 0, 0};
        cur = nxt; cA = nA; cB = nB; ++ui;
        if constexpr (Epi::PREFETCH) Em.prefetch(cur, wr, wc, fr, fq);
        if constexpr (ALIGN_EPI) { if (wr == 1) PG8_BAR; }
    }
    PG8_WAIT_V(0);
    if constexpr (!ALIGN_EPI) { if (wr == 0) PG8_BAR; }
    PG8_BAR;
    if constexpr (Epi::AFTER_DRAIN) { E.fused(acc, cur, wr, wc, fr, fq, lds, wid, lane); S.done(cur); }
#undef PG8_SA
#undef PG8_SB
#undef PG8_STAGE
#undef PG8_LDA
#undef PG8_LDB
#undef PG8_MMA
#undef PG8_WAIT_V
#undef PG8_WAIT_L
#undef PG8_BAR
#undef PG8_SCHED
}
}

#define XB_TMO      128
#define XB_XCNT(j)  (256  + 64 * (j))
#define XB_XSUB(j)  (1280 + 64 * (j))
#define XB_XGEN(j)  (2304 + 64 * (j))
#define XB_TOP      3328
#define XB_TOPGEN   3392
#define XCD_BAR_WORDS 3456
#define XB_SPIN_CAP (1u << 18)

__device__ __forceinline__ unsigned xb_ld(unsigned* p)              { return __hip_atomic_load(p, __ATOMIC_RELAXED, __HIP_MEMORY_SCOPE_AGENT); }
__device__ __forceinline__ unsigned xb_add(unsigned* p, unsigned v) { return __hip_atomic_fetch_add(p, v, __ATOMIC_RELAXED, __HIP_MEMORY_SCOPE_AGENT); }
__device__ __forceinline__ unsigned xb_xcc_id() { return (unsigned)__builtin_amdgcn_s_getreg((3 << 11) | 20) & 0xFu; }
#define XB_SPIN(cond, bar) do { unsigned _sp = 0; while (cond) { __builtin_amdgcn_s_sleep(1); \
    if ((++_sp & 255u) == 0u) { if (xb_ld(&(bar)[XB_TMO])) break; if (_sp > XB_SPIN_CAP) { atomicAdd(&(bar)[XB_TMO], 1u); break; } } } } while (0)

struct XcdBarrier {
    unsigned* bar; unsigned x;
    volatile LAS unsigned* st;
};

__device__ __forceinline__ XcdBarrier xcd_barrier_post(unsigned* bar, volatile LAS unsigned* st) {
    XcdBarrier b; b.bar = bar; b.x = xb_xcc_id(); b.st = st;
    if (threadIdx.x == 0) (void)xb_add(&bar[XB_XCNT(b.x)], 1u);
    return b;
}
__device__ __forceinline__ void xcd_barrier_complete(unsigned* bar, unsigned x, unsigned& nloc, unsigned& nx) {
    const unsigned G = gridDim.x * gridDim.y * gridDim.z;
    unsigned sum, cnt, mine, sp = 0u;
    for (;;) {
        sum = 0u; cnt = 0u; mine = 0u;
#pragma unroll
        for (unsigned j = 0; j < 16; ++j) { const unsigned c = xb_ld(&bar[XB_XCNT(j)]); sum += c; cnt += (c > 0u) ? 1u : 0u; mine = (j == x) ? c : mine; }
        if (sum == G) break;
        __builtin_amdgcn_s_sleep(1);
        if ((++sp & 255u) == 0u) { if (xb_ld(&bar[XB_TMO])) break; if (sp > XB_SPIN_CAP) { atomicAdd(&bar[XB_TMO], 1u); break; } }
    }
    nloc = mine > 0u ? mine : 1u; nx = cnt > 0u ? cnt : 1u;
}

__device__ __forceinline__ void xcd_barrier(const XcdBarrier& b) {
    asm volatile("s_waitcnt vmcnt(0)" ::: "memory");
    __syncthreads();
    if (threadIdx.x == 0) {
        unsigned* bar = b.bar;
        __builtin_amdgcn_s_waitcnt(0);
        unsigned nloc = b.st[0], nx = b.st[1];
        if (nloc == 0u) { xcd_barrier_complete(bar, b.x, nloc, nx); b.st[0] = nloc; b.st[1] = nx; }
        const unsigned old = xb_add(&bar[XB_XSUB(b.x)], 1u);
        const unsigned gen = old / nloc;
        if (old + 1u == (gen + 1u) * nloc) {
            __builtin_amdgcn_fence(__ATOMIC_RELEASE, "agent");
            asm volatile("s_waitcnt vmcnt(0)" ::: "memory");
            const unsigned og = xb_add(&bar[XB_TOP], 1u);
            const unsigned tg = og / nx;
            if (og + 1u == (tg + 1u) * nx) xb_add(&bar[XB_TOPGEN], 1u);
            else XB_SPIN(xb_ld(&bar[XB_TOPGEN]) == tg, bar);
            __builtin_amdgcn_fence(__ATOMIC_ACQUIRE, "agent");
            xb_add(&bar[XB_XGEN(b.x)], 1u);
            asm volatile("s_waitcnt vmcnt(0)" ::: "memory");
        } else {
            XB_SPIN(xb_ld(&bar[XB_XGEN(b.x)]) == gen, bar);
            __builtin_amdgcn_fence(__ATOMIC_ACQUIRE, "agent");
            asm volatile("s_waitcnt vmcnt(0)" ::: "memory");
        }
    }
    __syncthreads();
}

constexpr int NWAVES = 8, NTHR = 512;
constexpr int D = 1024, NB = 8, SEQ = 8192, NMETA = 16;
constexpr int MX = NB * SEQ;
constexpr int META0 = MX;
constexpr int MV = MX + NMETA;
constexpr int TP = MX + 256;
constexpr int NT = TP / 256;
constexpr int XBCW = 1536, COLSW = 3328, DFF = 2816, NEXP = 8;
constexpr int IN0_SRC = 5904;
constexpr int IN0_N = 6144;
constexpr float ALPHA = 1.4142135623730951f;
constexpr float LN_EPS = 1e-5f;
constexpr int MOE_RMAX = 2 * MX + NEXP * 256;
constexpr int MOE_TMAX = MOE_RMAX / 256;
constexpr int MOE_CHUNK = 264;
constexpr int NCHUNK64 = MX / 64 + 1;

constexpr size_t MiB = 1u << 20;
constexpr size_t WS_CTL = 0, CTL_ZERO_BYTES = 1 * MiB;
constexpr size_t WS_H = 1 * MiB;
constexpr size_t WS_XBC = 130 * MiB;
constexpr size_t WS_COLS = 323 * MiB;
constexpr size_t WS_Y = 741 * MiB;
constexpr size_t WS_DT = 998 * MiB;
constexpr size_t WS_SM = 1003 * MiB;
constexpr size_t WS_WIN1T = WS_SM, WS_WOUT1T = WS_SM + 4 * MiB, WS_GXT = WS_SM + 6 * MiB, WS_GAT = WS_GXT + 256 * 1024;
constexpr size_t WS_WUPT = WS_SM + 6 * MiB + 512 * 1024, WS_AUPT = WS_WUPT + 128 * 1024, WS_GUPT = WS_AUPT + 128 * 1024;
constexpr size_t WS_TOPE = WS_SM + 7 * MiB, WS_TOPG = WS_TOPE + 256 * 1024, WS_SLOTP = WS_TOPG + 512 * 1024, WS_ROWTOK = WS_SLOTP + 512 * 1024;
constexpr size_t WS_TILEE = WS_SM + 9 * MiB;
constexpr size_t WS_CARP = WS_SM + 10 * MiB, WS_CARH = WS_SM + 15 * MiB;
constexpr size_t WS_END = 1024 * MiB;
static_assert(WS_CARH + (size_t)NCHUNK64 * 1024 * 4 <= WS_END, "ws map");
static_assert(WS_ROWTOK + (size_t)MOE_RMAX * 4 <= WS_TILEE, "ws map");
constexpr size_t WS_WEGU = WS_XBC, WS_WEDN = WS_XBC + 88 * MiB;
constexpr size_t WS_ACT0 = WS_COLS;
constexpr size_t WS_G1 = WS_Y, WS_XR = WS_Y + (size_t)TP * 2048;
constexpr size_t WS_LA = WS_COLS, WS_U = WS_COLS + 129 * MiB;
constexpr size_t WS_XG = WS_COLS, WS_YSLOT = WS_Y;
constexpr size_t WS_H8 = WS_COLS + 300 * MiB;
constexpr size_t WS_H81 = WS_COLS;
constexpr size_t WS_H80 = WS_Y;
constexpr size_t WS_SROW = WS_CARP, WS_SSLOT = WS_CARP + 1 * MiB;
static_assert(WS_YSLOT + (size_t)MOE_RMAX * 2048 <= WS_SM, "ws map");
constexpr size_t DO_Z = 0;
constexpr size_t DO_WINT = 129 * MiB, DO_WOUTT = 141 * MiB, DO_WGUT = 145 * MiB, DO_WDNT = 156 * MiB;
constexpr size_t DO_LIN = 162 * MiB;
constexpr size_t DO_WIN8 = 206 * MiB;
constexpr size_t DO_WGU8 = 200 * MiB;
constexpr size_t DO_SIDE = 214 * MiB;
constexpr size_t DO_DTX = 224 * MiB;
constexpr size_t DO_WDN8 = 241 * MiB;
constexpr size_t DO_WIN18 = 245 * MiB;
constexpr size_t WS_ACTM = WS_COLS + 130 * MiB;
static_assert(WS_ACTM + (size_t)MOE_CHUNK * 256 * DFF <= WS_Y, "ws map");
constexpr float ACT_CLIP = 8.0f;
constexpr float W_CLIP = 0.78f;
static_assert((size_t)MOE_CHUNK * 256 * DFF <= 256 * MiB && DO_WDNT + (size_t)D * DFF * 2 <= 256 * MiB, "d_out map");
constexpr int CW_BAR = 4096;
constexpr int CW_CNT = 16384;
constexpr int CW_CUR = 16384 + 64;
constexpr int CW_GRP = 16384 + 512;
constexpr int CW_EAMAX = 16384 + 128;

constexpr int RING_BYTES = 131072;
constexpr int LDSCTL_OFF = 146944, MISC_OFF = LDSCTL_OFF + 320;
constexpr int LDS_BYTES = 147456;

struct Args { const float* in[43]; float* out; unsigned char* ws; int ph_lo, ph_hi; };
struct Frame {
    const Args* A;
    LAS unsigned char* lds;
    volatile LAS unsigned* MISC;
    gu32* ctl;
    int tid, lane, wave, G;
    int wi, wn;
    unsigned char* ws; unsigned char* dout;
};
enum { I_X = 0, I_META, I_EV_W_IN, I_EV_CONV_W, I_EV_CONV_B, I_EV_DT_BIAS, I_EV_A_LOG, I_EV_D_SKIP, I_EV_SSM_NORM, I_EV_SHIFT_MU, I_EV_W0, I_EV_W_UP, I_EV_A0, I_EV_A_UP, I_EV_G_UP,
       I_EV_K_K, I_EV_K_A, I_EV_R_K, I_EV_LNX_G, I_EV_LNX_B, I_EV_W_OUT, I_EV_LN1_G, I_EV_LN1_B, I_EV_FFN_GU, I_EV_FFN_DN, I_EV_LN2_G, I_EV_LN2_B,
       I_OD_W_IN, I_OD_CONV_W, I_OD_CONV_B, I_OD_GX_W, I_OD_GX_B, I_OD_GA_W, I_OD_GA_B, I_OD_LAMBDA, I_OD_W_OUT, I_OD_LN1_G, I_OD_LN1_B, I_OD_ROUTER, I_OD_EXP_GU, I_OD_EXP_DN, I_OD_LN2_G, I_OD_LN2_B, N_IN };
static_assert(N_IN == 43, "inputs");

#define Q8_MAGIC 12582912.0f
__device__ __forceinline__ unsigned pack4_lowbytes(float f0, float f1, float f2, float f3) {
    const unsigned t1 = __builtin_amdgcn_perm(__builtin_bit_cast(unsigned, f1), __builtin_bit_cast(unsigned, f0), 0x0c0c0400u), t2 = __builtin_amdgcn_perm(__builtin_bit_cast(unsigned, f3), __builtin_bit_cast(unsigned, f2), 0x0c0c0400u);
    return t1 | (t2 << 16);
}
__device__ __forceinline__ unsigned q8pack4c(float a, float b, float c, float d, float inv) {
    return pack4_lowbytes(__builtin_amdgcn_fmed3f(a * inv, -127.f, 127.f) + Q8_MAGIC, __builtin_amdgcn_fmed3f(b * inv, -127.f, 127.f) + Q8_MAGIC, __builtin_amdgcn_fmed3f(c * inv, -127.f, 127.f) + Q8_MAGIC, __builtin_amdgcn_fmed3f(d * inv, -127.f, 127.f) + Q8_MAGIC);
}
__device__ __forceinline__ unsigned q8pack4(float a, float b, float c, float d, float inv) {
    return pack4_lowbytes(__builtin_fmaf(a, inv, Q8_MAGIC), __builtin_fmaf(b, inv, Q8_MAGIC), __builtin_fmaf(c, inv, Q8_MAGIC), __builtin_fmaf(d, inv, Q8_MAGIC));
}
typedef float accT[2][2][4][2] __attribute__((unused));
struct EpiIn0 {
    static constexpr bool PERM = true, AFTER_DRAIN = false, PREFETCH = false;
    bf16* Z; bf16* XBC; bf16* COLS; float* DT;
    __device__ __forceinline__ void operator()(const f32x4 (&acc)[2][2][4][2], const pg8::Unit& u, int wr, int wc, int fr, int fq) const {
        const int row0 = u.pm * 256 + wr * 64 + fr;
        if (u.pn == 23) {
            if (wc == 0 && fq < 2) {
#pragma unroll
                for (int ai = 0; ai < 2; ++ai)
#pragma unroll
                    for (int m = 0; m < 4; ++m) { float* p = DT + (size_t)(row0 + ai * 128 + m * 16) * 16 + 8 * fq; *(f32x4*)p = acc[ai][0][m][0]; *(f32x4*)(p + 4) = acc[ai][0][m][1]; }
            }
            return;
        }
        bf16* base; int ldc, ct;
        if (u.pn < 4) { base = Z; ldc = 1024; ct = u.pn; } else if (u.pn < 10) { base = XBC; ldc = XBCW; ct = u.pn - 4; } else { base = COLS; ldc = COLSW; ct = u.pn - 10; }
        const int col0 = ct * 256 + wc * 32 + 8 * fq;
#pragma unroll
        for (int ai = 0; ai < 2; ++ai)
#pragma unroll
            for (int m = 0; m < 4; ++m) { bf16* rowp = base + (size_t)(row0 + ai * 128 + m * 16) * ldc + col0;
#pragma unroll
                for (int bj = 0; bj < 2; ++bj) { const f32x4 v0 = acc[ai][bj][m][0], v1 = acc[ai][bj][m][1];
                    v4u w; w.x = cvt_pk_bf16(v0[0], v0[1]); w.y = cvt_pk_bf16(v0[2], v0[3]); w.z = cvt_pk_bf16(v1[0], v1[1]); w.w = cvt_pk_bf16(v1[2], v1[3]);
                    *(v4u*)(rowp + bj * 128) = w; } }
    }
};
struct EpiIn0I8 {
    static constexpr bool PERM = true, AFTER_DRAIN = false, PREFETCH = true;
    bf16* Z; bf16* XBC; bf16* COLS; float* DT; const float* srow; const unsigned* wamax; float sc[2][4];
    __device__ __forceinline__ void prefetch(const pg8::Unit& u, int wr, int wc, int fr, int fq) { const int row0 = u.pm * 256 + wr * 64 + fr; const float sw = __builtin_bit_cast(float, wamax[0]) * (1.0f / 127.0f);
#pragma unroll
        for (int ai = 0; ai < 2; ++ai)
#pragma unroll
            for (int m = 0; m < 4; ++m) sc[ai][m] = srow[row0 + ai * 128 + m * 16] * sw; }
    __device__ __forceinline__ void operator()(const pg8::i32x4 (&acc)[2][2][4][2], const pg8::Unit& u, int wr, int wc, int fr, int fq) const {
        const int row0 = u.pm * 256 + wr * 64 + fr;
        if (u.pn == 23) {
            if (wc == 0 && fq < 2) {
#pragma unroll
                for (int ai = 0; ai < 2; ++ai)
#pragma unroll
                    for (int m = 0; m < 4; ++m) { const int r = row0 + ai * 128 + m * 16; const float s = sc[ai][m]; float* p = DT + (size_t)r * 16 + 8 * fq; const pg8::i32x4 a0 = acc[ai][0][m][0], a1 = acc[ai][0][m][1];
                        *(f32x4*)p = (f32x4){(float)a0[0] * s, (float)a0[1] * s, (float)a0[2] * s, (float)a0[3] * s}; *(f32x4*)(p + 4) = (f32x4){(float)a1[0] * s, (float)a1[1] * s, (float)a1[2] * s, (float)a1[3] * s}; }
            }
            return;
        }
        bf16* base; int ldc, ct;
        if (u.pn < 4) { base = Z; ldc = 1024; ct = u.pn; } else if (u.pn < 10) { base = XBC; ldc = XBCW; ct = u.pn - 4; } else { base = COLS; ldc = COLSW; ct = u.pn - 10; }
        const int col0 = ct * 256 + wc * 32 + 8 * fq;
#pragma unroll
        for (int ai = 0; ai < 2; ++ai)
#pragma unroll
            for (int m = 0; m < 4; ++m) { const int r = row0 + ai * 128 + m * 16; const float s = sc[ai][m]; bf16* rowp = base + (size_t)r * ldc + col0;
#pragma unroll
                for (int bj = 0; bj < 2; ++bj) { const pg8::i32x4 v0 = acc[ai][bj][m][0], v1 = acc[ai][bj][m][1];
                    v4u w; w.x = cvt_pk_bf16((float)v0[0] * s, (float)v0[1] * s); w.y = cvt_pk_bf16((float)v0[2] * s, (float)v0[3] * s); w.z = cvt_pk_bf16((float)v1[0] * s, (float)v1[1] * s); w.w = cvt_pk_bf16((float)v1[2] * s, (float)v1[3] * s);
                    *(v4u*)(rowp + bj * 128) = w; } }
    }
};
struct EpiResid {
    static constexpr bool PERM = true, AFTER_DRAIN = false, PREFETCH = false;
    const bf16* Hres; bf16* S;
    __device__ __forceinline__ void operator()(const f32x4 (&acc)[2][2][4][2], const pg8::Unit& u, int wr, int wc, int fr, int fq) const {
        const int row0 = u.pm * 256 + wr * 64 + fr, col0 = u.pn * 256 + wc * 32 + 8 * fq;
v4u h[2][4][2];
#pragma unroll
        for (int ai = 0; ai < 2; ++ai)
#pragma unroll
            for (int m = 0; m < 4; ++m)
#pragma unroll
                for (int bj = 0; bj < 2; ++bj) h[ai][m][bj] = *(const v4u*)(Hres + (size_t)(row0 + ai * 128 + m * 16) * 1024 + col0 + bj * 128);
#pragma unroll
        for (int ai = 0; ai < 2; ++ai)
#pragma unroll
            for (int m = 0; m < 4; ++m) { const size_t off = (size_t)(row0 + ai * 128 + m * 16) * 1024 + col0;
#pragma unroll
                for (int bj = 0; bj < 2; ++bj) { const v4u hh = h[ai][m][bj]; const f32x4 v0 = acc[ai][bj][m][0], v1 = acc[ai][bj][m][1];
                    v4u w; w.x = cvt_pk_bf16(ALPHA * bflo(hh.x) + v0[0], ALPHA * bfhi(hh.x) + v0[1]); w.y = cvt_pk_bf16(ALPHA * bflo(hh.y) + v0[2], ALPHA * bfhi(hh.y) + v0[3]);
                    w.z = cvt_pk_bf16(ALPHA * bflo(hh.z) + v1[0], ALPHA * bfhi(hh.z) + v1[1]); w.w = cvt_pk_bf16(ALPHA * bflo(hh.w) + v1[2], ALPHA * bfhi(hh.w) + v1[3]);
                    *(v4u*)(S + off + bj * 128) = w; } }
    }
};
struct EpiSwiglu {
    static constexpr bool PERM = true, AFTER_DRAIN = false, PREFETCH = false;
    bf16* ACT; int row_sub;
    __device__ __forceinline__ void operator()(const f32x4 (&acc)[2][2][4][2], const pg8::Unit& u, int wr, int wc, int fr, int fq) const {
        const int row0 = u.pm * 256 + wr * 64 + fr - row_sub, col0 = u.pn * 128 + wc * 32 + 8 * fq;
#pragma unroll
        for (int ai = 0; ai < 2; ++ai)
#pragma unroll
            for (int m = 0; m < 4; ++m) { bf16* p = ACT + (size_t)(row0 + ai * 128 + m * 16) * DFF + col0;
                const f32x4 g0 = acc[ai][0][m][0], g1 = acc[ai][0][m][1], u0 = acc[ai][1][m][0], u1 = acc[ai][1][m][1];
                v4u w; w.x = cvt_pk_bf16(siluf_(g0[0]) * u0[0], siluf_(g0[1]) * u0[1]); w.y = cvt_pk_bf16(siluf_(g0[2]) * u0[2], siluf_(g0[3]) * u0[3]);
                w.z = cvt_pk_bf16(siluf_(g1[0]) * u1[0], siluf_(g1[1]) * u1[1]); w.w = cvt_pk_bf16(siluf_(g1[2]) * u1[2], siluf_(g1[3]) * u1[3]);
                *(v4u*)p = w; }
    }
};
template <bool OUT_I8> struct EpiSwigluI8 {
    static constexpr bool PERM = true, AFTER_DRAIN = false, PREFETCH = true;
    void* ACT; int row_sub; const float* sslot; const int* tile_e; const unsigned* eamax; float sc[2][4];
    __device__ __forceinline__ void prefetch(const pg8::Unit& u, int wr, int wc, int fr, int fq) { const int rowg = u.pm * 256 + wr * 64 + fr; const float sw = __builtin_bit_cast(float, eamax[tile_e ? u.pe : 0]) * (1.0f / 127.0f);
#pragma unroll
        for (int ai = 0; ai < 2; ++ai)
#pragma unroll
            for (int m = 0; m < 4; ++m) sc[ai][m] = sslot[rowg + ai * 128 + m * 16] * sw; }
    __device__ __forceinline__ void operator()(const pg8::i32x4 (&acc)[2][2][4][2], const pg8::Unit& u, int wr, int wc, int fr, int fq) const {
        const int rowg = u.pm * 256 + wr * 64 + fr, row0 = rowg - row_sub, col0 = u.pn * 128 + wc * 32 + 8 * fq;
#pragma unroll
        for (int ai = 0; ai < 2; ++ai)
#pragma unroll
            for (int m = 0; m < 4; ++m) { const float s = sc[ai][m];
                const pg8::i32x4 g0 = acc[ai][0][m][0], g1 = acc[ai][0][m][1], u0 = acc[ai][1][m][0], u1 = acc[ai][1][m][1]; float v[8];
                if (OUT_I8) {
                    const float k1 = -s * 1.4426950408889634f, k2 = s * s * (127.0f / ACT_CLIP);
#pragma unroll
                    for (int j = 0; j < 4; ++j) { const float ga = (float)g0[j], ua = (float)u0[j], gb = (float)g1[j], ub = (float)u1[j];
                        const float ra = fast_rcp(1.0f + __builtin_amdgcn_exp2f(ga * k1)) * k2, rb = fast_rcp(1.0f + __builtin_amdgcn_exp2f(gb * k1)) * k2;
                        v[j] = __builtin_amdgcn_fmed3f((ga * ua) * ra, -127.f, 127.f) + Q8_MAGIC; v[4 + j] = __builtin_amdgcn_fmed3f((gb * ub) * rb, -127.f, 127.f) + Q8_MAGIC; }
                    v2u w; w.x = pack4_lowbytes(v[0], v[1], v[2], v[3]); w.y = pack4_lowbytes(v[4], v[5], v[6], v[7]);
                    *(v2u*)((unsigned char*)ACT + (size_t)(row0 + ai * 128 + m * 16) * DFF + col0) = w; }
                else {
#pragma unroll
                    for (int j = 0; j < 4; ++j) { v[j] = siluf_((float)g0[j] * s) * ((float)u0[j] * s); v[4 + j] = siluf_((float)g1[j] * s) * ((float)u1[j] * s); }
                    v4u w; w.x = cvt_pk_bf16(v[0], v[1]); w.y = cvt_pk_bf16(v[2], v[3]); w.z = cvt_pk_bf16(v[4], v[5]); w.w = cvt_pk_bf16(v[6], v[7]);
                    *(v4u*)((bf16*)ACT + (size_t)(row0 + ai * 128 + m * 16) * DFF + col0) = w; } }
    }
};
struct EpiPlainI8 {
    static constexpr bool PERM = true, AFTER_DRAIN = false, PREFETCH = true;
    bf16* O; const int* tile_e; const unsigned* eamax; float s;
    __device__ __forceinline__ void prefetch(const pg8::Unit& u, int, int, int, int) { s = __builtin_bit_cast(float, eamax[u.pe]) * (1.0f / 127.0f) * (ACT_CLIP / 127.0f); }
    __device__ __forceinline__ void operator()(const pg8::i32x4 (&acc)[2][2][4][2], const pg8::Unit& u, int wr, int wc, int fr, int fq) const {
        const int row0 = u.pm * 256 + wr * 64 + fr, col0 = u.pn * 256 + wc * 32 + 8 * fq;
#pragma unroll
        for (int ai = 0; ai < 2; ++ai)
#pragma unroll
            for (int m = 0; m < 4; ++m) { bf16* rowp = O + (size_t)(row0 + ai * 128 + m * 16) * 1024 + col0;
#pragma unroll
                for (int bj = 0; bj < 2; ++bj) { const pg8::i32x4 v0 = acc[ai][bj][m][0], v1 = acc[ai][bj][m][1];
                    v4u w; w.x = cvt_pk_bf16((float)v0[0] * s, (float)v0[1] * s); w.y = cvt_pk_bf16((float)v0[2] * s, (float)v0[3] * s); w.z = cvt_pk_bf16((float)v1[0] * s, (float)v1[1] * s); w.w = cvt_pk_bf16((float)v1[2] * s, (float)v1[3] * s);
                    *(v4u*)(rowp + bj * 128) = w; } }
    }
};
struct EpiResidI8 {
    static constexpr bool PERM = true, AFTER_DRAIN = false, PREFETCH = true;
    const bf16* Hres; bf16* S; const unsigned* eamax; float s;
    __device__ __forceinline__ void prefetch(const pg8::Unit&, int, int, int, int) { s = __builtin_bit_cast(float, eamax[0]) * (1.0f / 127.0f) * (ACT_CLIP / 127.0f); }
    __device__ __forceinline__ void operator()(const pg8::i32x4 (&acc)[2][2][4][2], const pg8::Unit& u, int wr, int wc, int fr, int fq) const {
        const int row0 = u.pm * 256 + wr * 64 + fr, col0 = u.pn * 256 + wc * 32 + 8 * fq;
v4u h[2][4][2];
#pragma unroll
        for (int ai = 0; ai < 2; ++ai)
#pragma unroll
            for (int m = 0; m < 4; ++m)
#pragma unroll
                for (int bj = 0; bj < 2; ++bj) h[ai][m][bj] = *(const v4u*)(Hres + (size_t)(row0 + ai * 128 + m * 16) * 1024 + col0 + bj * 128);
#pragma unroll
        for (int ai = 0; ai < 2; ++ai)
#pragma unroll
            for (int m = 0; m < 4; ++m) { const size_t off = (size_t)(row0 + ai * 128 + m * 16) * 1024 + col0;
#pragma unroll
                for (int bj = 0; bj < 2; ++bj) { const v4u hh = h[ai][m][bj]; const pg8::i32x4 v0 = acc[ai][bj][m][0], v1 = acc[ai][bj][m][1];
                    v4u w; w.x = cvt_pk_bf16(ALPHA * bflo(hh.x) + (float)v0[0] * s, ALPHA * bfhi(hh.x) + (float)v0[1] * s); w.y = cvt_pk_bf16(ALPHA * bflo(hh.y) + (float)v0[2] * s, ALPHA * bfhi(hh.y) + (float)v0[3] * s);
                    w.z = cvt_pk_bf16(ALPHA * bflo(hh.z) + (float)v1[0] * s, ALPHA * bfhi(hh.z) + (float)v1[1] * s); w.w = cvt_pk_bf16(ALPHA * bflo(hh.w) + (float)v1[2] * s, ALPHA * bfhi(hh.w) + (float)v1[3] * s);
                    *(v4u*)(S + off + bj * 128) = w; } }
    }
};
__device__ __forceinline__ float gelu_tanh(float x) { const float y = 1.5957691216057308f * (x + 0.044715f * x * x * x); return x * sigmoidf_(y); }
struct EpiIn1 {
    static constexpr bool PERM = true, AFTER_DRAIN = false, PREFETCH = false;
    bf16* G1; bf16* XR;
    __device__ __forceinline__ void operator()(const f32x4 (&acc)[2][2][4][2], const pg8::Unit& u, int wr, int wc, int fr, int fq) const {
        const int row0 = u.pm * 256 + wr * 64 + fr, col0 = (u.pn & 3) * 256 + wc * 32 + 8 * fq; const bool gate = u.pn < 4; bf16* base = gate ? G1 : XR;
#pragma unroll
        for (int ai = 0; ai < 2; ++ai)
#pragma unroll
            for (int m = 0; m < 4; ++m) { bf16* rowp = base + (size_t)(row0 + ai * 128 + m * 16) * 1024 + col0;
#pragma unroll
                for (int bj = 0; bj < 2; ++bj) { f32x4 v0 = acc[ai][bj][m][0], v1 = acc[ai][bj][m][1];
                    if (gate) {
#pragma unroll
                        for (int j = 0; j < 4; ++j) { v0[j] = gelu_tanh(v0[j]); v1[j] = gelu_tanh(v1[j]); } }
                    v4u w; w.x = cvt_pk_bf16(v0[0], v0[1]); w.y = cvt_pk_bf16(v0[2], v0[3]); w.z = cvt_pk_bf16(v1[0], v1[1]); w.w = cvt_pk_bf16(v1[2], v1[3]);
                    *(v4u*)(rowp + bj * 128) = w; } }
    }
};
struct EpiIn1I8 {
    static constexpr bool PERM = true, AFTER_DRAIN = false, PREFETCH = true;
    bf16* G1; bf16* XR; const float* srow; const unsigned* eamax; float sc[2][4];
    __device__ __forceinline__ void prefetch(const pg8::Unit& u, int wr, int, int fr, int) { const int rowg = u.pm * 256 + wr * 64 + fr; const float sw = __builtin_bit_cast(float, eamax[0]) * (1.0f / 127.0f);
#pragma unroll
        for (int ai = 0; ai < 2; ++ai)
#pragma unroll
            for (int m = 0; m < 4; ++m) sc[ai][m] = srow[rowg + ai * 128 + m * 16] * sw; }
    __device__ __forceinline__ void operator()(const pg8::i32x4 (&acc)[2][2][4][2], const pg8::Unit& u, int wr, int wc, int fr, int fq) const {
        const int row0 = u.pm * 256 + wr * 64 + fr, col0 = (u.pn & 3) * 256 + wc * 32 + 8 * fq; const bool gate = u.pn < 4; bf16* base = gate ? G1 : XR;
#pragma unroll
        for (int ai = 0; ai < 2; ++ai)
#pragma unroll
            for (int m = 0; m < 4; ++m) { bf16* rowp = base + (size_t)(row0 + ai * 128 + m * 16) * 1024 + col0; const float s = sc[ai][m];
#pragma unroll
                for (int bj = 0; bj < 2; ++bj) { const pg8::i32x4 i0 = acc[ai][bj][m][0], i1 = acc[ai][bj][m][1]; f32x4 v0, v1;
#pragma unroll
                    for (int j = 0; j < 4; ++j) { v0[j] = (float)i0[j] * s; v1[j] = (float)i1[j] * s; }
                    if (gate) {
#pragma unroll
                        for (int j = 0; j < 4; ++j) { v0[j] = gelu_tanh(v0[j]); v1[j] = gelu_tanh(v1[j]); } }
                    v4u w; w.x = cvt_pk_bf16(v0[0], v0[1]); w.y = cvt_pk_bf16(v0[2], v0[3]); w.z = cvt_pk_bf16(v1[0], v1[1]); w.w = cvt_pk_bf16(v1[2], v1[3]);
                    *(v4u*)(rowp + bj * 128) = w; } }
    }
};
struct EpiPlain {
    static constexpr bool PERM = true, AFTER_DRAIN = false, PREFETCH = false;
    bf16* O;
    __device__ __forceinline__ void operator()(const f32x4 (&acc)[2][2][4][2], const pg8::Unit& u, int wr, int wc, int fr, int fq) const {
        const int row0 = u.pm * 256 + wr * 64 + fr, col0 = u.pn * 256 + wc * 32 + 8 * fq;
#pragma unroll
        for (int ai = 0; ai < 2; ++ai)
#pragma unroll
            for (int m = 0; m < 4; ++m) { bf16* rowp = O + (size_t)(row0 + ai * 128 + m * 16) * 1024 + col0;
#pragma unroll
                for (int bj = 0; bj < 2; ++bj) { const f32x4 v0 = acc[ai][bj][m][0], v1 = acc[ai][bj][m][1];
                    v4u w; w.x = cvt_pk_bf16(v0[0], v0[1]); w.y = cvt_pk_bf16(v0[2], v0[3]); w.z = cvt_pk_bf16(v1[0], v1[1]); w.w = cvt_pk_bf16(v1[2], v1[3]);
                    *(v4u*)(rowp + bj * 128) = w; } }
    }
};
struct MoeOrder {
    int toff[7]; int t0, nbt; pg8::StaticOrder so;
    __device__ __forceinline__ bool next(int i, pg8::Unit& u) const {
        const int L = i * so.G + so.c; if (L >= so.nwg) return false;
        const int nN = so.nN, nig = 8 * nN, nM1 = so.nM & ~63, nwg1 = nM1 * nN;
        if (L < nwg1) {
            const int xcd = L & 7, off = L >> 3, k = off / nig, w = off - k * nig;
            u.pm = (k * 8 + xcd) * 8 + (w & 7); u.pn = w >> 3;
        } else {
            const int nM2 = so.nM - nM1, nwg2 = nM2 * nN; int wgid = L - nwg1;
            { const int q = nwg2 / 8, r = nwg2 % 8, xcd = wgid % 8, off = wgid / 8; wgid = (xcd < r ? xcd * (q + 1) : r * (q + 1) + (xcd - r) * q) + off; }
            const int gid = wgid / nig, fm = gid * 8, gsz = (nM2 - fm) < 8 ? (nM2 - fm) : 8;
            u.pm = nM1 + fm + ((wgid % nig) % gsz); u.pn = (wgid % nig) / gsz;
        }
        u.pm += t0; int e = 0;
#pragma unroll
        for (int k = 0; k < 7; ++k) e += (u.pm >= toff[k]) ? 1 : 0;
        u.pe = e; u.pb = e * nbt + u.pn; return true;
    }
    __device__ __forceinline__ void a_ready(const pg8::Unit&) const {}
    __device__ __forceinline__ void done(const pg8::Unit&) const {}
};

__device__ __forceinline__ void tr_load(float (&tv)[32], const float* W, int ldw, int k0, int c0, int lane) {
#pragma unroll
    for (int i = 0; i < 32; ++i) tv[i] = W[(size_t)(k0 + 2 * i + (lane >> 5)) * ldw + c0 + (lane & 31)];
}
__device__ __forceinline__ void tr_store(const float (&tv)[32], int K, int k0, bf16* WT, int n0, int nvalid, LAS float* scr, int lane) {
#pragma unroll
    for (int i = 0; i < 32; ++i) scr[(2 * i + (lane >> 5)) * 33 + (lane & 31)] = tv[i];
    LDS_WAIT(); asm volatile("" ::: "memory");
    const int c = lane & 7;
#pragma unroll
    for (int j = 0; j < 4; ++j) { const int n = (lane >> 3) + 8 * j; const LAS float* s = scr + (8 * c) * 33 + n;
        v4u o; o.x = cvt_pk_bf16(s[0 * 33], s[1 * 33]); o.y = cvt_pk_bf16(s[2 * 33], s[3 * 33]); o.z = cvt_pk_bf16(s[4 * 33], s[5 * 33]); o.w = cvt_pk_bf16(s[6 * 33], s[7 * 33]);
        if (n >= nvalid) o = (v4u){0u, 0u, 0u, 0u};
        *(GAS v4u*)(WT + (size_t)(n0 + n) * K + k0 + 8 * c) = o; }
    LDS_WAIT(); asm volatile("" ::: "memory");
}
__device__ __forceinline__ void tr_store_i8(const float (&tv)[32], int K, int k0, unsigned char* WT, int n0, float inv, LAS float* scr, int lane) {
#pragma unroll
    for (int i = 0; i < 32; ++i) scr[(2 * i + (lane >> 5)) * 33 + (lane & 31)] = tv[i];
    LDS_WAIT(); asm volatile("" ::: "memory");
    const int c = lane & 7;
#pragma unroll
    for (int j = 0; j < 4; ++j) { const int n = (lane >> 3) + 8 * j; const LAS float* s = scr + (8 * c) * 33 + n;
        v2u o; o.x = q8pack4c(s[0 * 33], s[1 * 33], s[2 * 33], s[3 * 33], inv); o.y = q8pack4c(s[4 * 33], s[5 * 33], s[6 * 33], s[7 * 33], inv);
        *(GAS v2u*)(WT + (size_t)(n0 + n) * K + k0 + 8 * c) = o; }
    LDS_WAIT(); asm volatile("" ::: "memory");
}
template <int KIND, bool I8> __device__ __forceinline__ void tr_matrix_x(Frame& F, const float* W, int ldw, int K, int N, void* WT, float inv, int& rot) {
    LAS float* scr = (LAS float*)(F.lds + F.wave * 16384);
    const int gw = F.wi * NWAVES + F.wave, NGW = F.wn * NWAVES, lane = F.lane;
    const int nblk = N / 32, nitems = (K / 64) * nblk;
    int start = gw - (rot % NGW); if (start < 0) start += NGW;
    rot += nitems;
    auto item = [&](int it, int& k0, int& c0, int& n0, int& nvalid, float& sc) { const int kb = it / nblk, nb = it % nblk; n0 = nb * 32; k0 = kb * 64; c0 = n0; nvalid = 32; sc = inv;
        if (KIND == 1) { if (n0 >= 5888) { c0 = 2560 + (n0 - 5888); nvalid = 5904 - n0; if (nvalid < 0) nvalid = 0; if (nvalid > 32) nvalid = 32; if (n0 >= 5904) sc = 0.f; if (c0 + 32 > IN0_SRC) c0 = 0; } else if (n0 >= 2560) c0 = n0 + 16; }
        if (KIND == 2) { const int pn = n0 >> 8, q = n0 & 255; c0 = q < 128 ? 128 * pn + q : DFF + 128 * pn + (q - 128); } };
    auto put = [&](const float (&tv)[32], int k0, int n0, int nvalid, float sc) { if (I8) tr_store_i8(tv, K, k0, (unsigned char*)WT, n0, sc, scr, lane); else tr_store(tv, K, k0, (bf16*)WT, n0, nvalid, scr, lane); };
    float ta[32], tb[32]; int ka = 0, ca = 0, na = 0, va = 0, kb_ = 0, cb = 0, nb_ = 0, vb = 0; float sa = 0.f, sb = 0.f;
    int it = start;
    if (it < nitems) { item(it, ka, ca, na, va, sa); tr_load(ta, W, ldw, ka, ca, lane); }
    while (it < nitems) {
        const int it2 = it + NGW;
        if (it2 < nitems) { item(it2, kb_, cb, nb_, vb, sb); tr_load(tb, W, ldw, kb_, cb, lane); }
        put(ta, ka, na, va, sa);
        if (it2 >= nitems) break;
        const int it3 = it2 + NGW;
        if (it3 < nitems) { item(it3, ka, ca, na, va, sa); tr_load(ta, W, ldw, ka, ca, lane); }
        put(tb, kb_, nb_, vb, sb);
        it = it3;
    }
}
template <int KIND> __device__ __forceinline__ void tr_matrix(Frame& F, const float* W, int ldw, int K, int N, bf16* WT, int& rot) { tr_matrix_x<KIND, false>(F, W, ldw, K, N, (void*)WT, 0.f, rot); }
template <int KIND> __device__ __forceinline__ void tr_matrix_i8(Frame& F, const float* W, int ldw, int K, int N, unsigned char* WT, float inv, int& rot) { tr_matrix_x<KIND, true>(F, W, ldw, K, N, (void*)WT, inv, rot); }
struct LnAffine { f32x4 g0, g1, g2, g3, b0, b1, b2, b3; };
__device__ __forceinline__ LnAffine ln_affine(const float* g, const float* b, int lane) { LnAffine A;
    A.g0 = *(const f32x4*)(g + 8 * lane); A.g1 = *(const f32x4*)(g + 8 * lane + 4); A.g2 = *(const f32x4*)(g + 512 + 8 * lane); A.g3 = *(const f32x4*)(g + 512 + 8 * lane + 4);
    A.b0 = *(const f32x4*)(b + 8 * lane); A.b1 = *(const f32x4*)(b + 8 * lane + 4); A.b2 = *(const f32x4*)(b + 512 + 8 * lane); A.b3 = *(const f32x4*)(b + 512 + 8 * lane + 4); return A; }
__device__ __forceinline__ void ln_row(const v4u a, const v4u c, bf16* orow, const LnAffine& A, int lane, float (&y)[16]) {
    float v[16] = {bflo(a.x), bfhi(a.x), bflo(a.y), bfhi(a.y), bflo(a.z), bfhi(a.z), bflo(a.w), bfhi(a.w), bflo(c.x), bfhi(c.x), bflo(c.y), bfhi(c.y), bflo(c.z), bfhi(c.z), bflo(c.w), bfhi(c.w)};
    float s = 0.f;
#pragma unroll
    for (int j = 0; j < 16; ++j) s += v[j];
    const float mean = wave_sum(s) * (1.f / D); float s2 = 0.f;
#pragma unroll
    for (int j = 0; j < 16; ++j) { v[j] -= mean; s2 += v[j] * v[j]; }
    const float rstd = 1.f / sqrtf(wave_sum(s2) * (1.f / D) + LN_EPS);
#pragma unroll
    for (int j = 0; j < 4; ++j) { y[j] = v[j] * rstd * A.g0[j] + A.b0[j]; y[4 + j] = v[4 + j] * rstd * A.g1[j] + A.b1[j]; y[8 + j] = v[8 + j] * rstd * A.g2[j] + A.b2[j]; y[12 + j] = v[12 + j] * rstd * A.g3[j] + A.b3[j]; }
    v4u o0, o1; o0.x = cvt_pk_bf16(y[0], y[1]); o0.y = cvt_pk_bf16(y[2], y[3]); o0.z = cvt_pk_bf16(y[4], y[5]); o0.w = cvt_pk_bf16(y[6], y[7]);
    o1.x = cvt_pk_bf16(y[8], y[9]); o1.y = cvt_pk_bf16(y[10], y[11]); o1.z = cvt_pk_bf16(y[12], y[13]); o1.w = cvt_pk_bf16(y[14], y[15]);
    *(v4u*)(orow + 8 * lane) = o0; *(v4u*)(orow + 512 + 8 * lane) = o1;
}

__device__ __forceinline__ void p0_prologue(Frame& F) {
    int rot = 0;
    tr_matrix<1>(F, F.A->in[I_EV_W_IN], IN0_SRC, D, IN0_N, (bf16*)(F.dout + DO_WINT), rot);
    tr_matrix<0>(F, F.A->in[I_EV_W_UP], D, 64, D, (bf16*)(F.ws + WS_WUPT), rot);
    tr_matrix<0>(F, F.A->in[I_EV_A_UP], D, 64, D, (bf16*)(F.ws + WS_AUPT), rot);
    tr_matrix<0>(F, F.A->in[I_EV_G_UP], D, 128, D, (bf16*)(F.ws + WS_GUPT), rot);
    const int gw = blockIdx.x * NWAVES + F.wave, NGW = F.G * NWAVES;
    bf16* H = (bf16*)(F.ws + WS_H);
    for (int m = gw; m < TP; m += NGW) {
        GAS unsigned long long* o8 = (GAS unsigned long long*)(H + (size_t)m * D) + F.lane;
        if (m < MV) {
            const float* xrow = m < MX ? F.A->in[I_X] + (size_t)m * D : F.A->in[I_META] + (size_t)(m - MX) * D;
            const GAS f32x4* xr = (const GAS f32x4*)xrow + F.lane;
            f32x4 xv[4]; float am = 0.f;
#pragma unroll
            for (int j = 0; j < 4; ++j) { const f32x4 v = xr[64 * j]; xv[j] = v; o8[64 * j] = (unsigned long long)cvt_pk_bf16(v.x, v.y) | ((unsigned long long)cvt_pk_bf16(v.z, v.w) << 32); am = fmaxf(am, fmaxf(fmaxf(fabsf(v.x), fabsf(v.y)), fmaxf(fabsf(v.z), fabsf(v.w)))); }
            if (m < MX) {
                am = wave_max(am);
                const float inv = 127.0f / fmaxf(am, 1e-30f); unsigned* h8 = (unsigned*)((unsigned char*)(F.ws + WS_H80) + (size_t)m * D) + F.lane;
#pragma unroll
                for (int j = 0; j < 4; ++j) h8[64 * j] = q8pack4(xv[j].x, xv[j].y, xv[j].z, xv[j].w, inv);
                if (F.lane == 0) ((float*)(F.ws + WS_SROW))[m] = am * (1.0f / 127.0f); }
        } else {
#pragma unroll
            for (int j = 0; j < 4; ++j) o8[64 * j] = 0ull;
        }
    }
}
__device__ __forceinline__ void late_weights(Frame& F) {
    int rot = 0;
    tr_matrix<0>(F, F.A->in[I_EV_W_OUT], D, 2048, D, (bf16*)(F.dout + DO_WOUTT), rot);
    tr_matrix<2>(F, F.A->in[I_EV_FFN_GU], 2 * DFF, D, 2 * DFF, (bf16*)(F.dout + DO_WGUT), rot);
    tr_matrix<0>(F, F.A->in[I_EV_FFN_DN], D, DFF, D, (bf16*)(F.dout + DO_WDNT), rot);
    tr_matrix<0>(F, F.A->in[I_OD_W_IN], 2048, D, 2048, (bf16*)(F.ws + WS_WIN1T), rot);
    tr_matrix<0>(F, F.A->in[I_OD_W_OUT], D, D, D, (bf16*)(F.ws + WS_WOUT1T), rot);
    for (int hb = 0; hb < 8; ++hb) {
        tr_matrix<0>(F, F.A->in[I_OD_GX_W] + hb * 128 * 128, 128, 128, 128, (bf16*)(F.ws + WS_GXT) + hb * 128 * 128, rot);
        tr_matrix<0>(F, F.A->in[I_OD_GA_W] + hb * 128 * 128, 128, 128, 128, (bf16*)(F.ws + WS_GAT) + hb * 128 * 128, rot);
    }
}
__device__ __forceinline__ float amax_stream(Frame& F, const f32x4* w, size_t n4) {
#define AM4(v) fmaxf(fmaxf(fabsf((v).x), fabsf((v).y)), fmaxf(fabsf((v).z), fabsf((v).w)))
    const size_t st = (size_t)F.wn * NTHR; size_t i = (size_t)F.wi * NTHR + F.tid; float m0 = 0.f, m1 = 0.f, m2 = 0.f, m3 = 0.f;
    for (; i + 3 * st < n4; i += 4 * st) { const f32x4 a = w[i], b = w[i + st], c = w[i + 2 * st], d = w[i + 3 * st]; m0 = fmaxf(m0, AM4(a)); m1 = fmaxf(m1, AM4(b)); m2 = fmaxf(m2, AM4(c)); m3 = fmaxf(m3, AM4(d)); }
    for (; i < n4; i += st) { const f32x4 a = w[i]; m0 = fmaxf(m0, AM4(a)); }
    return fmaxf(fmaxf(m0, m1), fmaxf(m2, m3));
#undef AM4
}
template <bool EARLY> __device__ __forceinline__ void expert_amax_phase(Frame& F) {
    const size_t n4 = (size_t)D * 2 * DFF / 4;
    if (!EARLY) for (int e = 0; e < NEXP; ++e) { const f32x4* w = (const f32x4*)(F.A->in[I_OD_EXP_GU] + (size_t)e * D * 2 * DFF); float m = W_CLIP * wave_max(amax_stream(F, w, n4));
        if (F.lane == 0) __hip_atomic_fetch_max((unsigned*)(F.ctl + CW_EAMAX + e), __builtin_bit_cast(unsigned, m), RLX_AGENT); }
    if (!EARLY) for (int e = 0; e < NEXP; ++e) { const size_t m4 = (size_t)D * DFF / 4; const f32x4* w = (const f32x4*)(F.A->in[I_OD_EXP_DN] + (size_t)e * DFF * D); float m = W_CLIP * wave_max(amax_stream(F, w, m4));
        if (F.lane == 0) __hip_atomic_fetch_max((unsigned*)(F.ctl + CW_EAMAX + 16 + e), __builtin_bit_cast(unsigned, m), RLX_AGENT); }
    if (EARLY) { const size_t m4 = (size_t)D * IN0_SRC / 4; const f32x4* w = (const f32x4*)F.A->in[I_EV_W_IN]; float m = W_CLIP * wave_max(amax_stream(F, w, m4));
        if (F.lane == 0) __hip_atomic_fetch_max((unsigned*)(F.ctl + CW_EAMAX + 9), __builtin_bit_cast(unsigned, m), RLX_AGENT); }
    if (!EARLY) { const size_t m4 = (size_t)D * 2048 / 4; const f32x4* w = (const f32x4*)F.A->in[I_OD_W_IN]; float m = W_CLIP * wave_max(amax_stream(F, w, m4));
        if (F.lane == 0) __hip_atomic_fetch_max((unsigned*)(F.ctl + CW_EAMAX + 11), __builtin_bit_cast(unsigned, m), RLX_AGENT); }
    if (!EARLY) { const size_t m4 = (size_t)D * DFF / 4; const f32x4* w = (const f32x4*)F.A->in[I_EV_FFN_DN]; float m = W_CLIP * wave_max(amax_stream(F, w, m4));
        if (F.lane == 0) __hip_atomic_fetch_max((unsigned*)(F.ctl + CW_EAMAX + 10), __builtin_bit_cast(unsigned, m), RLX_AGENT); }
    if (!EARLY) { const size_t m4 = (size_t)D * 2 * DFF / 4; const f32x4* w = (const f32x4*)F.A->in[I_EV_FFN_GU]; float m = W_CLIP * wave_max(amax_stream(F, w, m4));
        if (F.lane == 0) __hip_atomic_fetch_max((unsigned*)(F.ctl + CW_EAMAX + 8), __builtin_bit_cast(unsigned, m), RLX_AGENT); }
}
__device__ __forceinline__ void convert_win8(Frame& F) {
    int rot = 0; const float amax = __builtin_bit_cast(float, __hip_atomic_load((unsigned*)(F.ctl + CW_EAMAX + 9), RLX_AGENT));
    tr_matrix_i8<1>(F, F.A->in[I_EV_W_IN], IN0_SRC, D, IN0_N, (unsigned char*)(F.dout + DO_WIN8), 127.0f / fmaxf(amax, 1e-30f), rot);
}
__device__ __forceinline__ void convert_wgu8(Frame& F) {
    int rot = 0; const float amax = __builtin_bit_cast(float, __hip_atomic_load((unsigned*)(F.ctl + CW_EAMAX + 8), RLX_AGENT));
    tr_matrix_i8<2>(F, F.A->in[I_EV_FFN_GU], 2 * DFF, D, 2 * DFF, (unsigned char*)(F.dout + DO_WGU8), 127.0f / fmaxf(amax, 1e-30f), rot);
    const float amaxd = __builtin_bit_cast(float, __hip_atomic_load((unsigned*)(F.ctl + CW_EAMAX + 10), RLX_AGENT));
    tr_matrix_i8<0>(F, F.A->in[I_EV_FFN_DN], D, DFF, D, (unsigned char*)(F.dout + DO_WDN8), 127.0f / fmaxf(amaxd, 1e-30f), rot);
    const float amaxi = __builtin_bit_cast(float, __hip_atomic_load((unsigned*)(F.ctl + CW_EAMAX + 11), RLX_AGENT));
    tr_matrix_i8<0>(F, F.A->in[I_OD_W_IN], 2048, D, 2048, (unsigned char*)(F.dout + DO_WIN18), 127.0f / fmaxf(amaxi, 1e-30f), rot);
}
__device__ __forceinline__ void convert_experts(Frame& F) {
    int rot = 0;
    for (int e = 0; e < NEXP; ++e) {
        const float amax = __builtin_bit_cast(float, __hip_atomic_load((unsigned*)(F.ctl + CW_EAMAX + e), RLX_AGENT));
        tr_matrix_i8<2>(F, F.A->in[I_OD_EXP_GU] + (size_t)e * D * 2 * DFF, 2 * DFF, D, 2 * DFF, (unsigned char*)(F.ws + WS_WEGU) + (size_t)e * 2 * DFF * D, 127.0f / fmaxf(amax, 1e-30f), rot);
        const float amaxd = __builtin_bit_cast(float, __hip_atomic_load((unsigned*)(F.ctl + CW_EAMAX + 16 + e), RLX_AGENT));
        tr_matrix_i8<0>(F, F.A->in[I_OD_EXP_DN] + (size_t)e * DFF * D, D, DFF, D, (unsigned char*)(F.ws + WS_WEDN) + (size_t)e * D * DFF, 127.0f / fmaxf(amaxd, 1e-30f), rot);
    }
}
__device__ __forceinline__ void row_to_i8(const float (&y)[16], unsigned char* h8row, float* srow, int lane) {
    float am = 0.f;
#pragma unroll
    for (int j = 0; j < 16; ++j) am = fmaxf(am, fabsf(y[j]));
    am = wave_max(am);
    const float inv = 127.0f / fmaxf(am, 1e-30f);
    v2u q0, q1; q0.x = q8pack4(y[0], y[1], y[2], y[3], inv); q0.y = q8pack4(y[4], y[5], y[6], y[7], inv); q1.x = q8pack4(y[8], y[9], y[10], y[11], inv); q1.y = q8pack4(y[12], y[13], y[14], y[15], inv);
    *(v2u*)(h8row + 8 * lane) = q0; *(v2u*)(h8row + 512 + 8 * lane) = q1; if (lane == 0) *srow = am * (1.0f / 127.0f);
}
template <bool WITH_I8> __device__ __forceinline__ void ln_phase(Frame& F, const bf16* S, bf16* H, const float* g, const float* b, size_t h8_off = WS_H80) {
    const int gw = blockIdx.x * NWAVES + F.wave, NGW = F.G * NWAVES;
    const LnAffine A = ln_affine(g, b, F.lane); v4u na = (v4u){0u, 0u, 0u, 0u}, nc = na;
    if (gw < MV) { na = *(const v4u*)(S + (size_t)gw * D + 8 * F.lane); nc = *(const v4u*)(S + (size_t)gw * D + 512 + 8 * F.lane); }
    for (int m = gw; m < MV; m += NGW) { const v4u a = na, c = nc; const int mn = m + NGW;
        if (mn < MV) { na = *(const v4u*)(S + (size_t)mn * D + 8 * F.lane); nc = *(const v4u*)(S + (size_t)mn * D + 512 + 8 * F.lane); }
        float y[16]; ln_row(a, c, H + (size_t)m * D, A, F.lane, y);
        if (WITH_I8 && m < MX) row_to_i8(y, (unsigned char*)(F.ws + h8_off) + (size_t)m * D, (float*)(F.ws + WS_SROW) + m, F.lane); }
}
__device__ __forceinline__ void zero_fill(Frame& F, void* p, size_t bytes) {
    GAS v4u* q = (GAS v4u*)p; const size_t n = bytes / 16;
    for (size_t i = (size_t)blockIdx.x * NTHR + F.tid; i < n; i += (size_t)F.G * NTHR) q[i] = (v4u){0u, 0u, 0u, 0u};
}

__device__ __forceinline__ int chunk_row(int ck, int t) {
    if (ck == MX / 64) return (t >= 0 && t < NMETA) ? META0 + t : -1;
    if (t >= 0) return ck * 64 + t;
    return (ck & 127) == 0 ? META0 + NMETA + t : ck * 64 + t;
}
constexpr int LRU_XC = 0, LRU_XF = 17408, LRU_RAW = 51200, LRU_LAU = 51200;
static_assert(LRU_LAU + 64 * 128 * 8 <= RING_BYTES, "lds");
__device__ __forceinline__ void lru_gates_phase(Frame& F) {
    const int tid = F.tid, lane = F.lane, wv = F.wave, fr = lane & 15, fq = lane >> 4;
    const int hb = blockIdx.x & 7, wslot = blockIdx.x >> 3, nslot = F.G >> 3;
    const bf16* XR = (const bf16*)(F.ws + WS_XR);
    bf16* LOGP = (bf16*)(F.ws + WS_LA); bf16* HLOC = (bf16*)(F.ws + WS_U);
    float* CARP = (float*)(F.ws + WS_CARP); float* CARH = (float*)(F.ws + WS_CARH);
    LAS unsigned char* L = F.lds;
    bf16x8 bx[4], ba[4];
    { const bf16* gx = (const bf16*)(F.ws + WS_GXT) + (size_t)hb * 16384 + (size_t)(16 * wv + fr) * 128 + 8 * fq;
      const bf16* ga = (const bf16*)(F.ws + WS_GAT) + (size_t)hb * 16384 + (size_t)(16 * wv + fr) * 128 + 8 * fq;
#pragma unroll
      for (int ks = 0; ks < 4; ++ks) { bx[ks] = *(const bf16x8*)(gx + 32 * ks); ba[ks] = *(const bf16x8*)(ga + 32 * ks); } }
    const int chl = 16 * wv + fr, ch = 128 * hb + chl;
    const float gxb = F.A->in[I_OD_GX_B][ch], gab = F.A->in[I_OD_GA_B][ch], c8sp = 8.0f * softplusf_(-F.A->in[I_OD_LAMBDA][ch]);
    const int c8 = tid & 15, tg = tid >> 4;
    float cw[4][8], cb[8];
#pragma unroll
    for (int e = 0; e < 8; ++e) { cb[e] = F.A->in[I_OD_CONV_B][128 * hb + 8 * c8 + e];
#pragma unroll
        for (int k = 0; k < 4; ++k) cw[k][e] = F.A->in[I_OD_CONV_W][k * D + 128 * hb + 8 * c8 + e]; }
    v4u pre[3];
    auto issue_raw = [&](int ck) {
#pragma unroll
        for (int j = 0; j < 3; ++j) { const int q = tid + 512 * j; pre[j] = (v4u){0u, 0u, 0u, 0u}; if (q < 67 * 16) { const int rr = q >> 4, cc = q & 15; const int row = chunk_row(ck, rr - 3);
            if (row >= 0) pre[j] = *(const v4u*)(XR + (size_t)row * D + 128 * hb + 8 * cc); } }
    };
    if (wslot < NCHUNK64) issue_raw(wslot);
    for (int ck = wslot; ck < NCHUNK64; ck += nslot) {
        __syncthreads();
#pragma unroll
        for (int j = 0; j < 3; ++j) { const int q = tid + 512 * j; if (q < 67 * 16) { const int rr = q >> 4, cc = q & 15; *(LAS v4u*)(L + LRU_RAW + rr * 272 + cc * 16) = pre[j]; } }
        if (ck + nslot < NCHUNK64) issue_raw(ck + nslot);
        __syncthreads();
#pragma unroll
        for (int j = 0; j < 2; ++j) { const int t = tg + 32 * j; float o[8];
#pragma unroll
            for (int e = 0; e < 8; ++e) o[e] = cb[e];
#pragma unroll
            for (int k = 0; k < 4; ++k) { const v4u v = *(const LAS v4u*)(L + LRU_RAW + (t + k) * 272 + c8 * 16);
                const float x[8] = {bflo(v.x), bfhi(v.x), bflo(v.y), bfhi(v.y), bflo(v.z), bfhi(v.z), bflo(v.w), bfhi(v.w)};
#pragma unroll
                for (int e = 0; e < 8; ++e) o[e] += cw[k][e] * x[e]; }
            *(LAS f32x4*)(L + LRU_XF + t * 528 + c8 * 32) = (f32x4){o[0], o[1], o[2], o[3]}; *(LAS f32x4*)(L + LRU_XF + t * 528 + c8 * 32 + 16) = (f32x4){o[4], o[5], o[6], o[7]};
            v4u w; w.x = cvt_pk_bf16(o[0], o[1]); w.y = cvt_pk_bf16(o[2], o[3]); w.z = cvt_pk_bf16(o[4], o[5]); w.w = cvt_pk_bf16(o[6], o[7]);
            *(LAS v4u*)(L + LRU_XC + t * 272 + c8 * 16) = w; }
        __syncthreads();
#pragma unroll
        for (int mt = 0; mt < 4; ++mt) { f32x4 ax = (f32x4){0.f, 0.f, 0.f, 0.f}, aa = (f32x4){0.f, 0.f, 0.f, 0.f};
#pragma unroll
            for (int ks = 0; ks < 4; ++ks) { const bf16x8 af = *(const LAS bf16x8*)(L + LRU_XC + (16 * mt + fr) * 272 + (32 * ks + 8 * fq) * 2);
                ax = __builtin_amdgcn_mfma_f32_16x16x32_bf16(af, bx[ks], ax, 0, 0, 0); aa = __builtin_amdgcn_mfma_f32_16x16x32_bf16(af, ba[ks], aa, 0, 0, 0); }
#pragma unroll
            for (int r = 0; r < 4; ++r) { const int t = 16 * mt + 4 * fq + r;
                const float gx = sigmoidf_(ax[r] + gxb), ga = sigmoidf_(aa[r] + gab);
                float la = -c8sp * ga; const float om = 1.0f - fast_exp(2.0f * la);
                float u = __builtin_amdgcn_sqrtf(om) * gx * *(const LAS float*)(L + LRU_XF + t * 528 + chl * 4);
                if (ck == MX / 64 && t >= NMETA) { la = 0.f; u = 0.f; }
                *(LAS f32x2*)(L + LRU_LAU + (t * 128 + chl) * 8) = (f32x2){la, u}; } }
        __syncthreads();
        { const int tq = tid >> 7, chn = tid & 127; float hl[16], cl[16]; float h = 0.f, cum = 0.f;
#pragma unroll
            for (int i = 0; i < 16; ++i) { const f32x2 v = *(const LAS f32x2*)(L + LRU_LAU + ((16 * tq + i) * 128 + chn) * 8); cum += v.x; h = fast_exp(v.x) * h + v.y; hl[i] = h; cl[i] = cum; }
            LAS f32x2* qs = (LAS f32x2*)(L + LRU_XC);
            qs[tq * 128 + chn] = (f32x2){cum, h};
            __syncthreads();
            float hin = 0.f, cin = 0.f;
#pragma unroll
            for (int q = 0; q < 3; ++q) if (q < tq) { const f32x2 v = qs[q * 128 + chn]; hin = fast_exp(v.x) * hin + v.y; cin += v.x; }
            const int nval = ck == MX / 64 ? NMETA : 64;
#pragma unroll
            for (int i = 0; i < 16; ++i) { const int t = 16 * tq + i; if (t < nval) { const size_t o = (size_t)chunk_row(ck, t) * D + 128 * hb + chn; const unsigned w = cvt_pk_bf16(hl[i] + fast_exp(cl[i]) * hin, cl[i] + cin); HLOC[o] = (bf16)(w & 0xffffu); LOGP[o] = (bf16)(w >> 16); } }
            if (tq == 3) { CARP[(size_t)ck * D + 128 * hb + chn] = fast_exp(cl[15] + cin); CARH[(size_t)ck * D + 128 * hb + chn] = hl[15] + fast_exp(cl[15]) * hin; } }
    }
}
__device__ __forceinline__ void lru_carry_phase(Frame& F) {
    const int gt = blockIdx.x * NTHR + F.tid; if (gt >= NB * D) return;
    const int b = gt >> 10, ch = gt & 1023;
    const float* __restrict__ CARP = (const float*)(F.ws + WS_CARP); const float* __restrict__ CARH = (const float*)(F.ws + WS_CARH); float* __restrict__ CIN = (float*)(F.ws + WS_DT);
    float h = CARH[(size_t)(MX / 64) * D + ch];
    for (int c0 = 0; c0 < 128; c0 += 16) { float p[16], hh[16];
#pragma unroll
        for (int j = 0; j < 16; ++j) { const size_t o = (size_t)(b * 128 + c0 + j) * D + ch; p[j] = CARP[o]; hh[j] = CARH[o]; }
#pragma unroll
        for (int j = 0; j < 16; ++j) { CIN[(size_t)(b * 128 + c0 + j) * D + ch] = h; h = p[j] * h + hh[j]; } }
}
__device__ __forceinline__ void lru_fix_phase(Frame& F) {
    const bf16* LOGP = (const bf16*)(F.ws + WS_LA); bf16* HL = (bf16*)(F.ws + WS_U); const bf16* G1 = (const bf16*)(F.ws + WS_G1); const float* CIN = (const float*)(F.ws + WS_DT);
    const size_t n = (size_t)MV * 128;
    for (size_t i = (size_t)blockIdx.x * NTHR + F.tid; i < n; i += (size_t)F.G * NTHR) {
        const int row = (int)(i >> 7), c = (int)(i & 127) * 8; const size_t o = (size_t)row * D + c;
        const v4u hv = *(const v4u*)(HL + o), pv = *(const v4u*)(LOGP + o), gv = *(const v4u*)(G1 + o);
        f32x4 c0 = (f32x4){0.f, 0.f, 0.f, 0.f}, c1 = c0;
        if (row < MX) { const float* cp = CIN + (size_t)(row >> 6) * D + c; c0 = *(const f32x4*)cp; c1 = *(const f32x4*)(cp + 4); }
        float y[8];
        y[0] = (bflo(hv.x) + fast_exp(bflo(pv.x)) * c0[0]) * bflo(gv.x); y[1] = (bfhi(hv.x) + fast_exp(bfhi(pv.x)) * c0[1]) * bfhi(gv.x);
        y[2] = (bflo(hv.y) + fast_exp(bflo(pv.y)) * c0[2]) * bflo(gv.y); y[3] = (bfhi(hv.y) + fast_exp(bfhi(pv.y)) * c0[3]) * bfhi(gv.y);
        y[4] = (bflo(hv.z) + fast_exp(bflo(pv.z)) * c1[0]) * bflo(gv.z); y[5] = (bfhi(hv.z) + fast_exp(bfhi(pv.z)) * c1[1]) * bfhi(gv.z);
        y[6] = (bflo(hv.w) + fast_exp(bflo(pv.w)) * c1[2]) * bflo(gv.w); y[7] = (bfhi(hv.w) + fast_exp(bfhi(pv.w)) * c1[3]) * bfhi(gv.w);
        v4u w; w.x = cvt_pk_bf16(y[0], y[1]); w.y = cvt_pk_bf16(y[2], y[3]); w.z = cvt_pk_bf16(y[4], y[5]); w.w = cvt_pk_bf16(y[6], y[7]);
        *(v4u*)(HL + o) = w;
    }
}

__device__ __forceinline__ void ln_router_phase(Frame& F, const bf16* S, bf16* H) {
    const int gw = blockIdx.x * NWAVES + F.wave, NGW = F.G * NWAVES, lane = F.lane;
    LAS unsigned* hist = (LAS unsigned*)(F.lds);
    if (F.tid < 8) hist[F.tid] = 0u;
    __syncthreads();
    { int* ROWTOK = (int*)(F.ws + WS_ROWTOK); float* SSLOT = (float*)(F.ws + WS_SSLOT); for (int i = blockIdx.x * NTHR + F.tid; i < MOE_RMAX; i += F.G * NTHR) { ROWTOK[i] = -1; SSLOT[i] = 0.f; } }
    const float* Wr = F.A->in[I_OD_ROUTER];
    float wr[16][8];
#pragma unroll
    for (int j = 0; j < 16; ++j) { const int col = (j >> 3) * 512 + 8 * lane + (j & 7); const f32x4 a = *(const f32x4*)(Wr + (size_t)col * 8), b = *(const f32x4*)(Wr + (size_t)col * 8 + 4);
        wr[j][0] = a[0]; wr[j][1] = a[1]; wr[j][2] = a[2]; wr[j][3] = a[3]; wr[j][4] = b[0]; wr[j][5] = b[1]; wr[j][6] = b[2]; wr[j][7] = b[3]; }
    unsigned* TOPE = (unsigned*)(F.ws + WS_TOPE); float* TOPG = (float*)(F.ws + WS_TOPG);
    const float* g = F.A->in[I_OD_LN1_G]; const float* b = F.A->in[I_OD_LN1_B];
    const LnAffine A = ln_affine(g, b, lane); v4u na = (v4u){0u, 0u, 0u, 0u}, nc = na;
    if (gw < MV) { na = *(const v4u*)(S + (size_t)gw * D + 8 * lane); nc = *(const v4u*)(S + (size_t)gw * D + 512 + 8 * lane); }
    for (int m = gw; m < MV; m += NGW) { const v4u a = na, c = nc; const int mn = m + NGW;
        if (mn < MV) { na = *(const v4u*)(S + (size_t)mn * D + 8 * lane); nc = *(const v4u*)(S + (size_t)mn * D + 512 + 8 * lane); }
        float y[16]; ln_row(a, c, H + (size_t)m * D, A, lane, y);
        if (m < MX) {
            row_to_i8(y, (unsigned char*)(F.ws + WS_H8) + (size_t)m * D, (float*)(F.ws + WS_SROW) + m, lane);
            float lg[8];
#pragma unroll
            for (int e = 0; e < 8; ++e) { float s = 0.f;
#pragma unroll
                for (int j = 0; j < 16; ++j) s += y[j] * wr[j][e];
                lg[e] = wave_sum(s); }
            int e0 = 0; float l0 = lg[0];
#pragma unroll
            for (int e = 1; e < 8; ++e) if (lg[e] > l0) { l0 = lg[e]; e0 = e; }
            int e1 = -1; float l1 = -3.0e38f;
#pragma unroll
            for (int e = 0; e < 8; ++e) if (e != e0 && lg[e] > l1) { l1 = lg[e]; e1 = e; }
            const float g0 = fast_rcp(1.0f + fast_exp(l1 - l0));
            if (lane == 0) { TOPE[m] = (unsigned)e0 | ((unsigned)e1 << 8); TOPG[2 * m] = g0; TOPG[2 * m + 1] = 1.0f - g0; __hip_atomic_fetch_add(hist + e0, 1u, __ATOMIC_RELAXED, __HIP_MEMORY_SCOPE_WORKGROUP); __hip_atomic_fetch_add(hist + e1, 1u, __ATOMIC_RELAXED, __HIP_MEMORY_SCOPE_WORKGROUP); }
        }
    }
    __syncthreads();
    if (F.tid < 8) __hip_atomic_fetch_add((unsigned*)(F.ctl + CW_CNT + F.tid), hist[F.tid], RLX_AGENT);
}
__device__ __forceinline__ int moe_offsets(Frame& F, int (&off)[9]) {
    volatile LAS unsigned* c = F.MISC + 16;
    if (F.MISC[15] != 0u) {
#pragma unroll
        for (int e = 0; e < 9; ++e) off[e] = __builtin_amdgcn_readfirstlane((int)c[e]);
        return off[8] >> 8; }
    off[0] = 0;
#pragma unroll
    for (int e = 0; e < 8; ++e) { const unsigned cn = __builtin_amdgcn_readfirstlane(__hip_atomic_load((unsigned*)(F.ctl + CW_CNT + e), RLX_AGENT)); off[e + 1] = off[e] + (int)((cn + 255u) & ~255u); }
    if (F.tid == 0) {
#pragma unroll
        for (int e = 0; e < 9; ++e) c[e] = (unsigned)off[e];
        F.MISC[15] = 1u; }
    return off[8] >> 8;
}
__device__ __forceinline__ void moe_dispatch_phase(Frame& F) {
    int off[9]; const int ntiles = moe_offsets(F, off);
    LAS unsigned* lcnt = (LAS unsigned*)(F.lds); LAS unsigned* lbase = lcnt + 8;
    LAS unsigned* sp = lcnt + 16;
    const unsigned char* H8 = (const unsigned char*)(F.ws + WS_H8); unsigned char* XG = (unsigned char*)(F.ws + WS_XG); const float* SROW = (const float*)(F.ws + WS_SROW); float* SSLOT = (float*)(F.ws + WS_SSLOT);
    const unsigned* TOPE = (const unsigned*)(F.ws + WS_TOPE); int* ROWTOK = (int*)(F.ws + WS_ROWTOK); unsigned* SLOTP = (unsigned*)(F.ws + WS_SLOTP); int* TILEE = (int*)(F.ws + WS_TILEE);
    if (blockIdx.x == 0) for (int t = F.tid; t < MOE_TMAX; t += NTHR) { int e = 0;
#pragma unroll
        for (int k = 1; k < 8; ++k) if (t * 256 >= off[k]) e = k;
        TILEE[t] = (t < ntiles) ? e : 0; }
    for (int base = blockIdx.x * 256; base < MX; base += F.G * 256) {
        __syncthreads();
        if (F.tid < 8) lcnt[F.tid] = 0u;
        __syncthreads();
        unsigned e0 = 0, e1 = 0, r0 = 0, r1 = 0; const int tok = base + F.tid;
        if (F.tid < 256) { const unsigned te = TOPE[tok]; e0 = te & 255u; e1 = te >> 8; r0 = __hip_atomic_fetch_add(lcnt + e0, 1u, __ATOMIC_RELAXED, __HIP_MEMORY_SCOPE_WORKGROUP); r1 = __hip_atomic_fetch_add(lcnt + e1, 1u, __ATOMIC_RELAXED, __HIP_MEMORY_SCOPE_WORKGROUP); }
        __syncthreads();
        if (F.tid < 8) lbase[F.tid] = __hip_atomic_fetch_add((unsigned*)(F.ctl + CW_CUR + F.tid), lcnt[F.tid], RLX_AGENT);
        __syncthreads();
        if (F.tid < 256) { int o0 = 0, o1 = 0;
#pragma unroll
            for (int k = 0; k < 8; ++k) { if ((int)e0 == k) o0 = off[k]; if ((int)e1 == k) o1 = off[k]; }
            const unsigned p0 = (unsigned)o0 + lbase[e0] + r0, p1 = (unsigned)o1 + lbase[e1] + r1;
            ROWTOK[p0] = tok; ROWTOK[p1] = tok; SLOTP[2 * tok] = p0; SLOTP[2 * tok + 1] = p1;
            const float sc = SROW[tok]; SSLOT[p0] = sc; SSLOT[p1] = sc; sp[2 * F.tid] = p0; sp[2 * F.tid + 1] = p1; }
        __syncthreads();
        for (int i0 = F.wave; i0 < 256; i0 += 4 * NWAVES) { v4u a[4];
#pragma unroll
            for (int k = 0; k < 4; ++k) a[k] = *(const v4u*)(H8 + (size_t)(base + i0 + k * NWAVES) * D + 16 * F.lane);
#pragma unroll
            for (int k = 0; k < 4; ++k) { const int i = i0 + k * NWAVES; const unsigned q0 = sp[2 * i], q1 = sp[2 * i + 1];
                *(v4u*)(XG + (size_t)q0 * D + 16 * F.lane) = a[k]; *(v4u*)(XG + (size_t)q1 * D + 16 * F.lane) = a[k]; } }
    }
}
__device__ __forceinline__ void moe_gather_phase(Frame& F) {
    int off[9]; const int nrows = moe_offsets(F, off) * 256;
    const int* ROWTOK = (const int*)(F.ws + WS_ROWTOK); unsigned char* XG = (unsigned char*)(F.ws + WS_XG); const unsigned char* H8 = (const unsigned char*)(F.ws + WS_H8);
    const float* SROW = (const float*)(F.ws + WS_SROW); float* SSLOT = (float*)(F.ws + WS_SSLOT);
    const int gw = blockIdx.x * NWAVES + F.wave, NGW = F.G * NWAVES, lane = F.lane;
    for (int r = gw; r < nrows; r += NGW) { const int tok = ROWTOK[r]; v4u a = (v4u){0u, 0u, 0u, 0u}; float sc = 0.f;
        if (tok >= 0) { a = *(const v4u*)(H8 + (size_t)tok * D + 16 * lane); sc = SROW[tok]; }
        *(v4u*)(XG + (size_t)r * D + 16 * lane) = a; if (lane == 0) SSLOT[r] = sc; }
}
__device__ __forceinline__ void final_phase(Frame& F, const bf16* H, const float* g, const float* b, float* out) {
    const int gw = blockIdx.x * NWAVES + F.wave, NGW = F.G * NWAVES; const int lane = F.lane;
    const unsigned* SLOTP = (const unsigned*)(F.ws + WS_SLOTP); const float* TOPG = (const float*)(F.ws + WS_TOPG); const bf16* YS = (const bf16*)(F.ws + WS_YSLOT);
    unsigned s0n = 0, s1n = 0; float g0n = 0.f, g1n = 0.f, g0c = 0.f, g1c = 0.f; v4u ra[2], rp[2], rq[2];
    if (gw < MX) { const unsigned t0 = SLOTP[2 * gw], t1 = SLOTP[2 * gw + 1]; g0c = TOPG[2 * gw]; g1c = TOPG[2 * gw + 1];
#pragma unroll
        for (int hlf = 0; hlf < 2; ++hlf) { const int co = hlf * 512 + 8 * lane; ra[hlf] = *(const v4u*)(H + (size_t)gw * D + co); rp[hlf] = *(const v4u*)(YS + (size_t)t0 * D + co); rq[hlf] = *(const v4u*)(YS + (size_t)t1 * D + co); } }
    if (gw + NGW < MX) { const int m1 = gw + NGW; s0n = SLOTP[2 * m1]; s1n = SLOTP[2 * m1 + 1]; g0n = TOPG[2 * m1]; g1n = TOPG[2 * m1 + 1]; }
    for (int m = gw; m < MX; m += NGW) {
        const float g0 = g0c, g1 = g1c; v4u a2[2], p2[2], q2[2];
#pragma unroll
        for (int hlf = 0; hlf < 2; ++hlf) { a2[hlf] = ra[hlf]; p2[hlf] = rp[hlf]; q2[hlf] = rq[hlf]; }
        const int m1 = m + NGW, m2 = m + 2 * NGW;
        if (m1 < MX) { g0c = g0n; g1c = g1n;
#pragma unroll
            for (int hlf = 0; hlf < 2; ++hlf) { const int co = hlf * 512 + 8 * lane; ra[hlf] = *(const v4u*)(H + (size_t)m1 * D + co); rp[hlf] = *(const v4u*)(YS + (size_t)s0n * D + co); rq[hlf] = *(const v4u*)(YS + (size_t)s1n * D + co); } }
        if (m2 < MX) { s0n = SLOTP[2 * m2]; s1n = SLOTP[2 * m2 + 1]; g0n = TOPG[2 * m2]; g1n = TOPG[2 * m2 + 1]; }
        float v[16];
#pragma unroll
        for (int hlf = 0; hlf < 2; ++hlf) { const v4u a = a2[hlf], p = p2[hlf], q = q2[hlf];
            v[8 * hlf + 0] = ALPHA * bflo(a.x) + g0 * bflo(p.x) + g1 * bflo(q.x); v[8 * hlf + 1] = ALPHA * bfhi(a.x) + g0 * bfhi(p.x) + g1 * bfhi(q.x);
            v[8 * hlf + 2] = ALPHA * bflo(a.y) + g0 * bflo(p.y) + g1 * bflo(q.y); v[8 * hlf + 3] = ALPHA * bfhi(a.y) + g0 * bfhi(p.y) + g1 * bfhi(q.y);
            v[8 * hlf + 4] = ALPHA * bflo(a.z) + g0 * bflo(p.z) + g1 * bflo(q.z); v[8 * hlf + 5] = ALPHA * bfhi(a.z) + g0 * bfhi(p.z) + g1 * bfhi(q.z);
            v[8 * hlf + 6] = ALPHA * bflo(a.w) + g0 * bflo(p.w) + g1 * bflo(q.w); v[8 * hlf + 7] = ALPHA * bfhi(a.w) + g0 * bfhi(p.w) + g1 * bfhi(q.w); }
        float s = 0.f;
#pragma unroll
        for (int j = 0; j < 16; ++j) s += v[j];
        const float mean = wave_sum(s) * (1.f / D); float s2 = 0.f;
#pragma unroll
        for (int j = 0; j < 16; ++j) { v[j] -= mean; s2 += v[j] * v[j]; }
        const float rstd = 1.f / sqrtf(wave_sum(s2) * (1.f / D) + LN_EPS);
        float* orow = out + (size_t)m * D;
#pragma unroll
        for (int q = 0; q < 4; ++q) { const int col = (q >> 1) * 512 + 8 * lane + (q & 1) * 4; const f32x4 gg = *(const f32x4*)(g + col), bb = *(const f32x4*)(b + col); f32x4 o;
#pragma unroll
            for (int j = 0; j < 4; ++j) o[j] = v[4 * q + j] * rstd * gg[j] + bb[j];
            *(f32x4*)(orow + col) = o; }
    }
}

#define WG_BAR() do { asm volatile("s_waitcnt lgkmcnt(0)" ::: "memory"); __builtin_amdgcn_s_barrier(); asm volatile("" ::: "memory"); } while (0)
__device__ __forceinline__ int seq_row(int b, int s) { return s < NMETA ? META0 + s : b * SEQ + s - NMETA; }
#define DPP_ADD(x, ctrl) ((x) + __builtin_bit_cast(float, __builtin_amdgcn_update_dpp(0, __builtin_bit_cast(int, (x)), (ctrl), 0xF, 0xF, false)))
__device__ __forceinline__ float dpp_sum8(float x) {
    x = DPP_ADD(x, 0xB1); x = DPP_ADD(x, 0x4E); x = DPP_ADD(x, 0x141); return x; }
__device__ __forceinline__ float dpp_sum16(float x) {
    x = DPP_ADD(x, 0xB1); x = DPP_ADD(x, 0x4E); x = DPP_ADD(x, 0x141); x = DPP_ADD(x, 0x140); return x; }
__device__ __forceinline__ void rwkv_lin_phase(Frame& F) {
    const bf16* COLS = (const bf16*)(F.ws + WS_COLS); bf16* LIN = (bf16*)(F.dout + DO_LIN); const float* mu = F.A->in[I_EV_SHIFT_MU] + 3072;
    const int n = MV * 32;
    for (int i = blockIdx.x * NTHR + F.tid; i < n; i += F.G * NTHR) { const int row = i >> 5, c = i & 31;
        int prow = row - 1; if (row == META0) prow = -1; else if (row < MX && (row & (SEQ - 1)) == 0) prow = META0 + NMETA - 1;
        const v4u cv = *(const v4u*)(COLS + (size_t)row * COLSW + 3072 + 8 * c); v4u pv = (v4u){0u, 0u, 0u, 0u}; if (prow >= 0) pv = *(const v4u*)(COLS + (size_t)prow * COLSW + 3072 + 8 * c);
        const float cx[8] = {bflo(cv.x), bfhi(cv.x), bflo(cv.y), bfhi(cv.y), bflo(cv.z), bfhi(cv.z), bflo(cv.w), bfhi(cv.w)}, px[8] = {bflo(pv.x), bfhi(pv.x), bflo(pv.y), bfhi(pv.y), bflo(pv.z), bfhi(pv.z), bflo(pv.w), bfhi(pv.w)};
        const f32x4 m0 = *(const f32x4*)(mu + 8 * c), m1 = *(const f32x4*)(mu + 8 * c + 4); float m[8];
#pragma unroll
        for (int e = 0; e < 8; ++e) { m[e] = cx[e] + (px[e] - cx[e]) * (e < 4 ? m0[e] : m1[e - 4]); if (c < 8) m[e] = 2.0f * sigmoidf_(2.0f * m[e]) - 1.0f; else if (c >= 16) m[e] = sigmoidf_(m[e]); }
        v4u w; w.x = cvt_pk_bf16(m[0], m[1]); w.y = cvt_pk_bf16(m[2], m[3]); w.z = cvt_pk_bf16(m[4], m[5]); w.w = cvt_pk_bf16(m[6], m[7]);
        *(v4u*)(LIN + (size_t)row * 256 + 8 * c) = w; }
}
constexpr int RC_OP = 0, RC_OPS = 15616, OP_KTT = 0, OP_RTT = 2304, OP_ATT = 4608, OP_KHT = 6912, OP_KT = 9216, OP_AT = 12288, OP_ZL = 15360;
constexpr int RC_CO = 31232, RC_COS = 10752, CO_KTT = 0, CO_RPT = 2304, CO_QPT = 4608, CO_W2 = 5376, CO_GL = 10496;
constexpr int RC_CV = 52736, RC_VB = 73216, RC_GB = 83456, RC_PSB = 93696, RC_PSS = 94976, RC_ZS = 95488, RC_SB = 97536, RC_OB = 106752, RC_SCR = 114944;
constexpr int SCW = 5376, SC_AFT = 0, SC_BF = 1024, SC_PT = 2048, SC_QFT = 2816, SC_KTK = 3840, SC_BTM = 4608;
constexpr int RC_ZERO = RC_SCR + 4 * SCW;
static_assert(RC_ZERO + 16 <= LDSCTL_OFF, "lds");
template <int KS, bool K16> __device__ __forceinline__ f32x4 mm16(const LAS unsigned char* Ap, int lda, const LAS unsigned char* Bp, int ldb, f32x4 acc, int fr, int fq, const LAS unsigned char* zero16 = nullptr) {
#pragma unroll
    for (int ks = 0; ks < KS; ++ks) { const LAS unsigned char* pa = Ap + fr * lda + (32 * ks + 8 * fq) * 2; const LAS unsigned char* pb = Bp + fr * ldb + (32 * ks + 8 * fq) * 2;
        if (K16) { pa = fq < 2 ? pa : zero16; pb = fq < 2 ? pb : zero16; }
        const v4u ar = *(const LAS v4u*)pa, br = *(const LAS v4u*)pb;
        acc = __builtin_amdgcn_mfma_f32_16x16x32_bf16(__builtin_bit_cast(bf16x8, ar), __builtin_bit_cast(bf16x8, br), acc, 0, 0, 0); }
    return acc;
}
__device__ __forceinline__ v2u pk4(float a, float b, float c, float d) { v2u w; w.x = cvt_pk_bf16(a, b); w.y = cvt_pk_bf16(c, d); return w; }
__device__ __forceinline__ void rwkv_unit(Frame& F, int b, int h) {
    const int lane = F.lane, wv = F.wave, fr = lane & 15, fq = lane >> 4;
    LAS unsigned char* L = F.lds;
    const f32x4 z4 = (f32x4){0.f, 0.f, 0.f, 0.f};
    if (wv < 4) {
        const int p = wv;
        for (int q = F.tid; q < 9216 / 4; q += 256) *(LAS unsigned*)(L + RC_SB + q * 4) = 0u;
        f32x4 st[4] = {z4, z4, z4, z4};
        LAS unsigned char* sc = L + RC_SCR + p * SCW; const LAS unsigned char* zr = L + RC_ZERO;
        if (F.tid < 4) *(LAS unsigned*)(L + RC_ZERO + 4 * F.tid) = 0u;
        for (int j = -3; j <= 513; ++j) {
            if (j >= 0 && j <= 512) { const LAS unsigned char* co = L + RC_CO + (j & 1) * RC_COS; LAS unsigned char* cv = L + RC_CV + (j & 3) * 5120 + 16 * p * 80; const LAS unsigned char* sb = L + RC_SB + 16 * p * 144;
                const f32x4 c = mm16<2, false>(co + CO_KTT, 144, sb, 144, z4, fr, fq);
                *(LAS v2u*)(cv + fr * 80 + 4 * fq * 2) = pk4(c[0], c[1], c[2], c[3]);
                f32x4 y = mm16<2, false>(co + CO_RPT, 144, sb, 144, z4, fr, fq);
                y = mm16<1, true>(co + CO_QPT, 48, cv + 32, 80, y, fr, fq, zr);
                LAS float* ob = (LAS float*)(L + RC_OB + (j & 1) * 4096) + 16 * p + fr;
#pragma unroll
                for (int r = 0; r < 4; ++r) ob[(4 * fq + r) * 64] = y[r];
                asm volatile("s_waitcnt lgkmcnt(0)" ::: "memory");
                const LAS float* gl = (const LAS float*)(co + CO_GL);
#pragma unroll
                for (int kt = 0; kt < 4; ++kt) { const f32x4 g4 = *(const LAS f32x4*)(gl + 16 * kt + 4 * fq);
                    st[kt] = mm16<1, false>(co + CO_W2 + 16 * kt * 80, 80, cv, 80, st[kt] * g4, fr, fq);
                    *(LAS v2u*)(L + RC_SB + (16 * p + fr) * 144 + (16 * kt + 4 * fq) * 2) = pk4(st[kt][0], st[kt][1], st[kt][2], st[kt][3]); } }
            const int J = j + 1;
            if (J >= 0 && J <= 512) { const LAS unsigned char* op = L + RC_OP + (J & 1) * RC_OPS; LAS unsigned char* co = L + RC_CO + (J & 1) * RC_COS;
                { bf16x8 fa[2], fh[2], fk[2], fx[2];
#pragma unroll
                  for (int ks = 0; ks < 2; ++ks) { const int o = fr * 144 + (32 * ks + 8 * fq) * 2; fa[ks] = *(const LAS bf16x8*)(op + OP_ATT + o); fh[ks] = *(const LAS bf16x8*)(op + OP_KHT + o); fk[ks] = *(const LAS bf16x8*)(op + OP_KTT + o); fx[ks] = *(const LAS bf16x8*)(op + OP_RTT + o); }
                  f32x4 dA = z4, dB = z4, dP = z4, dQ = z4;
#pragma unroll
                  for (int ks = 0; ks < 2; ++ks) { dA = __builtin_amdgcn_mfma_f32_16x16x32_bf16(fa[ks], fk[ks], dA, 0, 0, 0); dB = __builtin_amdgcn_mfma_f32_16x16x32_bf16(fh[ks], fk[ks], dB, 0, 0, 0); dP = __builtin_amdgcn_mfma_f32_16x16x32_bf16(fa[ks], fx[ks], dP, 0, 0, 0); }
                  if (p == 0) {
#pragma unroll
                      for (int ks = 0; ks < 2; ++ks) dQ = __builtin_amdgcn_mfma_f32_16x16x32_bf16(fh[ks], fx[ks], dQ, 0, 0, 0); }
#pragma unroll
                  for (int r = 0; r < 4; ++r) { const int tau = 4 * fq + r; const bool lt = tau < fr, le = tau <= fr; dB[r] = lt ? dB[r] : 0.f;     dP[r] = le ? dP[r] : 0.f; dQ[r] = le ? dQ[r] : 0.f;
                      *(LAS float*)(sc + SC_BF + (tau * 16 + fr) * 4) = dB[r]; }
                  *(LAS f32x4*)(sc + SC_AFT + (fr * 16 + 4 * fq) * 4) = dA;
                  *(LAS v2u*)(sc + SC_PT + fr * 48 + 4 * fq * 2) = pk4(dP[0], dP[1], dP[2], dP[3]);
                  if (p == 0) *(LAS f32x4*)(sc + SC_QFT + (fr * 16 + 4 * fq) * 4) = dQ; }
                asm volatile("s_waitcnt lgkmcnt(0)" ::: "memory");
                { const int hl = lane & 31; float X[16];
                  if (hl < 16) { const v4u k0 = *(const LAS v4u*)(op + OP_KT + (16 * p + hl) * 48), k1 = *(const LAS v4u*)(op + OP_KT + (16 * p + hl) * 48 + 16);
                      X[0] = bflo(k0.x); X[1] = bfhi(k0.x); X[2] = bflo(k0.y); X[3] = bfhi(k0.y); X[4] = bflo(k0.z); X[5] = bfhi(k0.z); X[6] = bflo(k0.w); X[7] = bfhi(k0.w);
                      X[8] = bflo(k1.x); X[9] = bfhi(k1.x); X[10] = bflo(k1.y); X[11] = bfhi(k1.y); X[12] = bflo(k1.z); X[13] = bfhi(k1.z); X[14] = bflo(k1.w); X[15] = bfhi(k1.w); }
                  else { const LAS f32x4* bp = (const LAS f32x4*)(sc + SC_BF + (hl - 16) * 64); const f32x4 b0 = bp[0], b1 = bp[1], b2 = bp[2], b3 = bp[3];
                      X[0] = b0[0]; X[1] = b0[1]; X[2] = b0[2]; X[3] = b0[3]; X[4] = b1[0]; X[5] = b1[1]; X[6] = b1[2]; X[7] = b1[3]; X[8] = b2[0]; X[9] = b2[1]; X[10] = b2[2]; X[11] = b2[3]; X[12] = b3[0]; X[13] = b3[1]; X[14] = b3[2]; X[15] = b3[3]; }
#define NFMA(acc, x, a) asm("v_fma_f32 %0, -%1, %2, %0" : "+v"(acc) : "v"(x), "v"(a))
#pragma unroll
                  for (int tb = 0; tb < 4; ++tb) {
#pragma unroll
                      for (int t4 = 0; t4 < 4 * tb; t4 += 4) { f32x4 av[4];
#pragma unroll
                          for (int c = 0; c < 4; ++c) av[c] = *(const LAS f32x4*)(sc + SC_AFT + ((4 * tb + c) * 16 + t4) * 4);
#pragma unroll
                          for (int e = 0; e < 4; ++e) {
#pragma unroll
                              for (int c = 0; c < 4; ++c) NFMA(X[4 * tb + c], X[t4 + e], av[c][e]); } }
                      f32x4 dv[4];
#pragma unroll
                      for (int c = 1; c < 4; ++c) dv[c] = *(const LAS f32x4*)(sc + SC_AFT + ((4 * tb + c) * 16 + 4 * tb) * 4);
                      NFMA(X[4 * tb + 1], X[4 * tb], dv[1][0]); NFMA(X[4 * tb + 2], X[4 * tb], dv[2][0]); NFMA(X[4 * tb + 3], X[4 * tb], dv[3][0]);
                      NFMA(X[4 * tb + 2], X[4 * tb + 1], dv[2][1]); NFMA(X[4 * tb + 3], X[4 * tb + 1], dv[3][1]);
                      NFMA(X[4 * tb + 3], X[4 * tb + 2], dv[3][2]); }
                  if (lane < 32) { v4u w0, w1; w0.x = cvt_pk_bf16(X[0], X[1]); w0.y = cvt_pk_bf16(X[2], X[3]); w0.z = cvt_pk_bf16(X[4], X[5]); w0.w = cvt_pk_bf16(X[6], X[7]);
                      w1.x = cvt_pk_bf16(X[8], X[9]); w1.y = cvt_pk_bf16(X[10], X[11]); w1.z = cvt_pk_bf16(X[12], X[13]); w1.w = cvt_pk_bf16(X[14], X[15]);
                      if (hl < 16) { *(LAS v4u*)(sc + SC_KTK + hl * 48) = w0; *(LAS v4u*)(sc + SC_KTK + hl * 48 + 16) = w1;
                          LAS unsigned char* kt = co + CO_KTT + (16 * p + hl) * 2; const unsigned ww[8] = {w0.x, w0.y, w0.z, w0.w, w1.x, w1.y, w1.z, w1.w};
#pragma unroll
                          for (int e = 0; e < 8; ++e) { *(LAS unsigned short*)(kt + (2 * e) * 144) = (unsigned short)(ww[e] & 0xffffu); *(LAS unsigned short*)(kt + (2 * e + 1) * 144) = (unsigned short)(ww[e] >> 16); } }
                      else { *(LAS v4u*)(sc + SC_BTM + (hl - 16) * 48) = w0; *(LAS v4u*)(sc + SC_BTM + (hl - 16) * 48 + 16) = w1; } } }
                asm volatile("s_waitcnt lgkmcnt(0)" ::: "memory");
                { const f32x4 d = mm16<1, true>(sc + SC_KTK, 48, sc + SC_PT, 48, z4, fr, fq, zr);
                  const v2u rt = *(const LAS v2u*)(op + OP_RTT + fr * 144 + (16 * p + 4 * fq) * 2);
                  *(LAS v2u*)(co + CO_RPT + fr * 144 + (16 * p + 4 * fq) * 2) = pk4(bflo(rt.x) - d[0], bfhi(rt.x) - d[1], bflo(rt.y) - d[2], bfhi(rt.y) - d[3]); }
                if (p == 0) { const f32x4 d = mm16<1, true>(sc + SC_BTM, 48, sc + SC_PT, 48, z4, fr, fq, zr);
                  const f32x4 qv = *(const LAS f32x4*)(sc + SC_QFT + (fr * 16 + 4 * fq) * 4);
                  *(LAS v2u*)(co + CO_QPT + fr * 48 + 4 * fq * 2) = pk4(qv[0] - d[0], qv[1] - d[1], qv[2] - d[2], qv[3] - d[3]); }
                { const int k = 16 * p + fr; const float gl = fast_exp(-*(const LAS float*)(op + OP_ZL + k * 4));
                  const f32x4 d = mm16<1, true>(sc + SC_BTM, 48, op + OP_AT + 16 * p * 48, 48, z4, fr, fq, zr);
                  float m2[4];
#pragma unroll
                  for (int r = 0; r < 4; ++r) m2[r] = (bf2f(*(const LAS unsigned short*)(op + OP_KHT + (4 * fq + r) * 144 + k * 2)) - d[r]) * gl;
                  *(LAS v2u*)(co + CO_W2 + k * 80 + (16 + 4 * fq) * 2) = pk4(m2[0], m2[1], m2[2], m2[3]);
                  const v2u at = *(const LAS v2u*)(op + OP_AT + k * 48 + 4 * fq * 2);
                  *(LAS v2u*)(co + CO_W2 + k * 80 + 4 * fq * 2) = pk4(-bflo(at.x) * gl, -bfhi(at.x) * gl, -bflo(at.y) * gl, -bfhi(at.y) * gl);
                  if (fq == 0) *(LAS float*)(co + CO_GL + k * 4) = gl; } }
            WG_BAR();
        }
    } else {
        const int pw = wv - 4, ch = 16 * pw + fr, hj = 64 * h + ch;
        const bf16* COLS = (const bf16*)(F.ws + WS_COLS); const bf16* LIN = (const bf16*)(F.dout + DO_LIN); bf16* Y = (bf16*)(F.ws + WS_Y);
        const float w0 = F.A->in[I_EV_W0][hj], a0 = F.A->in[I_EV_A0][hj], kkc = F.A->in[I_EV_K_K][hj], kac = F.A->in[I_EV_K_A][hj], rkc = F.A->in[I_EV_R_K][hj];
        const float mur = F.A->in[I_EV_SHIFT_MU][hj], muk = F.A->in[I_EV_SHIFT_MU][1024 + hj], muv = F.A->in[I_EV_SHIFT_MU][2048 + hj];
        float lng[4], lnb[4];
#pragma unroll
        for (int r = 0; r < 4; ++r) { lng[r] = F.A->in[I_EV_LNX_G][64 * h + fr + 16 * r]; lnb[r] = F.A->in[I_EV_LNX_B][64 * h + fr + 16 * r]; }
        bf16x8 bw[2], ba[2], bg[4];
        { const bf16* pwp = (const bf16*)(F.ws + WS_WUPT) + (size_t)hj * 64 + 8 * fq; const bf16* pap = (const bf16*)(F.ws + WS_AUPT) + (size_t)hj * 64 + 8 * fq; const bf16* pgp = (const bf16*)(F.ws + WS_GUPT) + (size_t)hj * 128 + 8 * fq;
#pragma unroll
          for (int ks = 0; ks < 2; ++ks) { bw[ks] = *(const bf16x8*)(pwp + 32 * ks); ba[ks] = *(const bf16x8*)(pap + 32 * ks); }
#pragma unroll
          for (int ks = 0; ks < 4; ++ks) bg[ks] = *(const bf16x8*)(pgp + 32 * ks); }
        unsigned cr[4], ck[4], cv[4], qr0 = 0u, qk0 = 0u, qv0 = 0u; bf16x8 lf[8];
        const unsigned xsel = (hj & 1) ? 0x03020c0cu : 0x01000c0cu;
#define XBF(w) __builtin_bit_cast(float, __builtin_amdgcn_perm((w), (w), xsel))
        const __amdgpu_buffer_rsrc_t rsC = __builtin_amdgcn_make_buffer_rsrc((void*)(F.ws + WS_COLS), 0, (int)((size_t)TP * COLSW * 2), 0x00020000);
        const __amdgpu_buffer_rsrc_t rsL = __builtin_amdgcn_make_buffer_rsrc((void*)(F.dout + DO_LIN), 0, (int)((size_t)TP * 256 * 2), 0x00020000);
        const __amdgpu_buffer_rsrc_t rsY = __builtin_amdgcn_make_buffer_rsrc((void*)(F.ws + WS_Y), 0, (int)((size_t)TP * 2048 * 2), 0x00020000);
        const unsigned hjb = (unsigned)(hj * 2) & ~3u;
        auto issue_loads = [&](int J) { const int s0 = 16 * J + 4 * fq;
            const unsigned o0 = (unsigned)seq_row(b, s0) * (COLSW * 2) + hjb;
#pragma unroll
            for (int r = 0; r < 4; ++r) { const unsigned o = o0 + r * (COLSW * 2); cr[r] = __builtin_amdgcn_raw_buffer_load_b32(rsC, o, 0, 0); ck[r] = __builtin_amdgcn_raw_buffer_load_b32(rsC, o + 2048, 0, 0); cv[r] = __builtin_amdgcn_raw_buffer_load_b32(rsC, o, 4096, 0); }
            qr0 = 0u; qk0 = 0u; qv0 = 0u; if (s0 > 0) { const unsigned o = (unsigned)seq_row(b, s0 - 1) * (COLSW * 2) + hjb; qr0 = __builtin_amdgcn_raw_buffer_load_b32(rsC, o, 0, 0); qk0 = __builtin_amdgcn_raw_buffer_load_b32(rsC, o + 2048, 0, 0); qv0 = __builtin_amdgcn_raw_buffer_load_b32(rsC, o, 4096, 0); }
            const unsigned lo = (unsigned)seq_row(b, 16 * J + fr) * 512 + 16 * fq;
#pragma unroll
            for (int ks = 0; ks < 8; ++ks) lf[ks] = __builtin_bit_cast(bf16x8, __builtin_amdgcn_raw_buffer_load_b128(rsL, lo + 64 * ks, 0, 0));
        };
        float kkv_k[4] = {0.f, 0.f, 0.f, 0.f}, a_k[4] = {0.f, 0.f, 0.f, 0.f}, rm_k[4] = {0.f, 0.f, 0.f, 0.f}, k2_k[4] = {0.f, 0.f, 0.f, 0.f}, zc_k[4] = {0.f, 0.f, 0.f, 0.f};
        issue_loads(0);
        for (int j = -3; j <= 513; ++j) {
            if (j + 2 >= 0 && j + 2 <= 512) { const int J = j + 2; LAS unsigned char* op = L + RC_OP + (J & 1) * RC_OPS; const LAS f32x4* ps4 = (const LAS f32x4*)(L + RC_PSS + (J & 1) * 256) + fq; const LAS float* zs = (const LAS float*)(L + RC_ZS + (J & 1) * 1024) + ch * 4;
                float zb = 0.f;
#pragma unroll
                for (int q = 0; q < 3; ++q) if (q < fq) zb += zs[q];
                const f32x4 ss4 = (ps4[0] + ps4[4]) + (ps4[8] + ps4[12]);
                float kt4[4], at4[4]; float eprev = fast_exp(-zb);
#pragma unroll
                for (int r = 0; r < 4; ++r) { const int t = 4 * fq + r; const float kk = kkv_k[r] * rsqrtf(fmaxf(ss4[r], 1e-24f));
                    const float em = fast_exp(-(zb + zc_k[r])), ep = fast_rcp(em);
                    kt4[r] = kk * eprev; at4[r] = kk * a_k[r] * ep; eprev = em;
                    const unsigned u1 = cvt_pk_bf16(kt4[r], rm_k[r] * em), u2 = cvt_pk_bf16(at4[r], k2_k[r] * ep);
                    *(LAS unsigned short*)(op + OP_KTT + t * 144 + ch * 2) = (unsigned short)(u1 & 0xffffu); *(LAS unsigned short*)(op + OP_RTT + t * 144 + ch * 2) = (unsigned short)(u1 >> 16);
                    *(LAS unsigned short*)(op + OP_ATT + t * 144 + ch * 2) = (unsigned short)(u2 & 0xffffu); *(LAS unsigned short*)(op + OP_KHT + t * 144 + ch * 2) = (unsigned short)(u2 >> 16); }
                *(LAS v2u*)(op + OP_KT + ch * 48 + 4 * fq * 2) = pk4(kt4[0], kt4[1], kt4[2], kt4[3]); *(LAS v2u*)(op + OP_AT + ch * 48 + 4 * fq * 2) = pk4(at4[0], at4[1], at4[2], at4[3]);
                if (fq == 3) *(LAS float*)(op + OP_ZL + ch * 4) = zb + zc_k[3]; }
            const bool xv = j + 3 <= 512; const int JX = j + 3;
            f32x4 aw = z4, aa = z4, ag = z4;
            if (xv) {
#pragma unroll
                for (int ks = 0; ks < 2; ++ks) { aw = __builtin_amdgcn_mfma_f32_16x16x32_bf16(lf[ks], bw[ks], aw, 0, 0, 0); aa = __builtin_amdgcn_mfma_f32_16x16x32_bf16(lf[2 + ks], ba[ks], aa, 0, 0, 0); }
#pragma unroll
                for (int ks = 0; ks < 4; ++ks) ag = __builtin_amdgcn_mfma_f32_16x16x32_bf16(lf[4 + ks], bg[ks], ag, 0, 0, 0);
                float vm4[4], zrun = 0.f, sq[4], bo[4]; float pr = XBF(qr0), pk = XBF(qk0), pv = XBF(qv0);
                LAS unsigned char* vbp = L + RC_VB + (JX % 5) * 2048 + (4 * fq * 64 + ch) * 2; LAS unsigned char* gbp = L + RC_GB + (JX % 5) * 2048 + (4 * fq * 64 + ch) * 2;
#pragma unroll
                for (int r = 0; r < 4; ++r) {
                    const float rc = XBF(cr[r]), kc = XBF(ck[r]), vc = XBF(cv[r]);
                    const float rm = rc + (pr - rc) * mur, km = kc + (pk - kc) * muk, vm = vc + (pv - vc) * muv; pr = rc; pk = kc; pv = vc;
                    const float z = 0.6065306597126334f * sigmoidf_(w0 + aw[r]);
                    const float a = sigmoidf_(a0 + aa[r]);
                    const float kkv = km * kkc, k2 = km * (1.0f + (a - 1.0f) * kac);
                    sq[r] = kkv * kkv; bo[r] = rm * k2 * rkc;
                    zrun += z; kkv_k[r] = kkv; a_k[r] = a; rm_k[r] = rm; k2_k[r] = k2; zc_k[r] = zrun; vm4[r] = vm;
                    const unsigned u = cvt_pk_bf16(vm, ag[r]);
                    *(LAS unsigned short*)(vbp + r * 128) = (unsigned short)(u & 0xffffu); *(LAS unsigned short*)(gbp + r * 128) = (unsigned short)(u >> 16); }
                { const bool b3 = (fr & 8) != 0, b2 = (fr & 4) != 0, b1 = (fr & 2) != 0; float k4[4], k2v[2];
#pragma unroll
                  for (int i = 0; i < 4; ++i) { const float keep = b3 ? bo[i] : sq[i], send = b3 ? sq[i] : bo[i]; k4[i] = keep + DPPF(send, 0x140); }
#pragma unroll
                  for (int i = 0; i < 2; ++i) { const float keep = b2 ? k4[2 + i] : k4[i], send = b2 ? k4[i] : k4[2 + i]; k2v[i] = keep + DPPF(send, 0x141); }
                  const float keep = b1 ? k2v[1] : k2v[0], send = b1 ? k2v[0] : k2v[1]; float k1 = keep + DPPF(send, 0x4E); k1 += DPPF(k1, 0xB1);
                  const int idx = fr >> 1; LAS unsigned char* dst = (idx < 4 ? L + RC_PSS + (JX & 1) * 256 : L + RC_PSB + (JX % 5) * 256) + (pw * 16 + 4 * fq + (idx & 3)) * 4;
                  if (!(fr & 1)) *(LAS float*)dst = k1; }
                *(LAS v2u*)(L + RC_CV + (JX & 3) * 5120 + ch * 80 + (16 + 4 * fq) * 2) = pk4(vm4[0], vm4[1], vm4[2], vm4[3]);
                *(LAS float*)(L + RC_ZS + (JX & 1) * 1024 + (ch * 4 + fq) * 4) = zrun;
                if (JX + 1 <= 512) issue_loads(JX + 1); }
            if (j >= 1) { const int J = j - 1, t = 4 * pw + fq; const LAS unsigned char* ob = L + RC_OB + (J & 1) * 4096 + (t * 64 + fr) * 4; const LAS unsigned char* vb = L + RC_VB + (J % 5) * 2048 + (t * 64 + fr) * 2; const LAS unsigned char* gb = L + RC_GB + (J % 5) * 2048 + (t * 64 + fr) * 2;
                float o[4], s = 0.f;
#pragma unroll
                for (int r = 0; r < 4; ++r) { o[r] = *(const LAS float*)(ob + 64 * r); s += o[r]; }
                const float mean = dpp_sum16(s) * (1.0f / 64.0f); float q = 0.f;
#pragma unroll
                for (int r = 0; r < 4; ++r) { o[r] -= mean; q += o[r] * o[r]; }
                const float rstd = rsqrtf(dpp_sum16(q) * (1.0f / 64.0f) + 64e-5f);
                const LAS float* pb = (const LAS float*)(L + RC_PSB + (J % 5) * 256) + t; const float bon = (pb[0] + pb[16]) + (pb[32] + pb[48]);
                const unsigned yo = (unsigned)seq_row(b, 16 * J + t) * 4096 + (1024 + 64 * h + fr) * 2; float y[4];
#pragma unroll
                for (int r = 0; r < 4; ++r) y[r] = (o[r] * rstd * lng[r] + lnb[r] + bon * bf2f(*(const LAS unsigned short*)(vb + 32 * r))) * bf2f(*(const LAS unsigned short*)(gb + 32 * r));
                const unsigned u0 = cvt_pk_bf16(y[0], y[1]), u1 = cvt_pk_bf16(y[2], y[3]);
                __builtin_amdgcn_raw_buffer_store_b16((unsigned short)(u0 & 0xffffu), rsY, yo, 0, 0); __builtin_amdgcn_raw_buffer_store_b16((unsigned short)(u0 >> 16), rsY, yo + 32, 0, 0);
                __builtin_amdgcn_raw_buffer_store_b16((unsigned short)(u1 & 0xffffu), rsY, yo + 64, 0, 0); __builtin_amdgcn_raw_buffer_store_b16((unsigned short)(u1 >> 16), rsY, yo + 96, 0, 0); }
            WG_BAR();
        }
    }
}
__device__ __forceinline__ void ssd_conv_prepass(Frame& F) {
    bf16* XBC = (bf16*)(F.ws + WS_XBC); bf16* SIDE = (bf16*)(F.dout + DO_SIDE);
    const float* CWp = F.A->in[I_EV_CONV_W]; const float* CBp = F.A->in[I_EV_CONV_B];
    const int cgl = F.tid & 63, run = F.tid >> 6;
    for (int u = F.wi; u < 1025 * 3; u += F.wn) { const int id = u / 3, col = 512 * (u % 3) + 8 * cgl;
        v4u raw[11];
#pragma unroll
        for (int i = 0; i < 11; ++i) { const int l = 8 * run - 3 + i; int row = -1;
            if (id < 1024) row = l >= 0 ? 64 * id + l : ((id & 127) == 0 ? META0 + 16 + l : 64 * id + l);
            else if (l >= 48) row = META0 + l - 48;
            raw[i] = (v4u){0u, 0u, 0u, 0u}; if (row >= 0) raw[i] = *(const v4u*)(XBC + (size_t)row * XBCW + col); }
        f32x4 w[4][2], bb[2];
#pragma unroll
        for (int k = 0; k < 4; ++k) { w[k][0] = *(const f32x4*)(CWp + k * XBCW + col); w[k][1] = *(const f32x4*)(CWp + k * XBCW + col + 4); }
        bb[0] = *(const f32x4*)(CBp + col); bb[1] = *(const f32x4*)(CBp + col + 4);
        asm volatile("s_waitcnt vmcnt(0)" ::: "memory");
        __syncthreads();
#pragma unroll
        for (int o = 0; o < 8; ++o) { const int l = 8 * run + o; float y[8] = {bb[0][0], bb[0][1], bb[0][2], bb[0][3], bb[1][0], bb[1][1], bb[1][2], bb[1][3]};
#pragma unroll
            for (int k = 0; k < 4; ++k) { const v4u v = raw[o + k];
                y[0] += w[k][0][0] * bflo(v.x); y[1] += w[k][0][1] * bfhi(v.x); y[2] += w[k][0][2] * bflo(v.y); y[3] += w[k][0][3] * bfhi(v.y);
                y[4] += w[k][1][0] * bflo(v.z); y[5] += w[k][1][1] * bfhi(v.z); y[6] += w[k][1][2] * bflo(v.w); y[7] += w[k][1][3] * bfhi(v.w); }
            v4u q; q.x = cvt_pk_bf16(siluf_(y[0]), siluf_(y[1])); q.y = cvt_pk_bf16(siluf_(y[2]), siluf_(y[3])); q.z = cvt_pk_bf16(siluf_(y[4]), siluf_(y[5])); q.w = cvt_pk_bf16(siluf_(y[6]), siluf_(y[7]));
            if (id < 1024 || l >= 48) { const int row = id < 1024 ? 64 * id + l : META0 + l - 48;
                bf16* dst = l >= 61 ? SIDE + ((size_t)id * 3 + (l - 61)) * XBCW + col : XBC + (size_t)row * XBCW + col;
                *(v4u*)dst = q; } }
    }
    const int gw = F.wi * NWAVES + F.wave, NGW = F.wn * NWAVES, lane = F.lane; const float* DT = (const float*)(F.ws + WS_DT); f32x4* DTX = (f32x4*)(F.dout + DO_DTX);
    for (int wk = gw; wk < 1025 * 16; wk += NGW) { const int id = wk >> 4, h = wk & 15; const float Ah = -__expf(F.A->in[I_EV_A_LOG][h]), dtb = F.A->in[I_EV_DT_BIAS][h];
        int row = -1; if (id < 1024) row = 64 * id + lane; else if (lane >= 48) row = META0 + lane - 48;
        float dt = 0.f; if (row >= 0) dt = softplusf_(DT[(size_t)row * 16 + h] + dtb);
        float acs = dt * Ah;
#pragma unroll
        for (int o = 1; o < 64; o <<= 1) { const float t = __shfl_up(acs, o); if (lane >= o) acs += t; }
        const float tot = __shfl(acs, 63);
        DTX[(size_t)wk * 64 + lane] = (f32x4){dt, acs, fast_exp(tot - acs) * dt, fast_exp(acs)}; }
}
constexpr int SD_XT = 0, SD_BM = 9216, SD_CM = 26624, SD_PS = 44032, SD_BT = 61440, SD_CW = 79872, SD_DT = 86272, SD_ACS = 86528, SD_WGT = 86784, SD_EAC = 87040, SD_HALO = 87296, SD_R1 = 91264;
constexpr int SD_RAW = SD_R1, SD_XWT = SD_R1, SD_MM = SD_R1 + 9216, SD_YT = SD_R1 + 18432, SD_RSTR = 656, SD_HSZ = 3 * 656;
static_assert(SD_R1 + 64 * SD_RSTR <= LDSCTL_OFF && SD_HALO + 2 * SD_HSZ <= SD_R1, "lds");
__device__ __forceinline__ int sd_swz(int row, int col) { return row * 144 + ((((col >> 3) ^ (row >> 3)) & 7) << 4) + (col & 7) * 2; }
__device__ __forceinline__ void ssd_unit(Frame& F, int b, int h) {
    const int tid = F.tid, lane = F.lane, wv = F.wave, fr = lane & 15, fq = lane >> 4, g = h >> 3;
    LAS unsigned char* L = F.lds;
    const bf16* XBC = (const bf16*)(F.ws + WS_XBC); const bf16* Z = (const bf16*)(F.dout + DO_Z); const float* DT = (const float*)(F.ws + WS_DT); bf16* Y = (bf16*)(F.ws + WS_Y);
    const float Dh = F.A->in[I_EV_D_SKIP][h];
    const bf16* SIDE = (const bf16*)(F.dout + DO_SIDE); const f32x4* DTX = (const f32x4*)(F.dout + DO_DTX);
    for (int q = tid; q < 64 * 272 / 4; q += NTHR) *(LAS unsigned*)(L + SD_PS + q * 4) = 0u;
    f32x4 st[4];
#pragma unroll
    for (int pt = 0; pt < 4; ++pt) st[pt] = (f32x4){0.f, 0.f, 0.f, 0.f};
    int it_l[5], it_cg[5], it_col[5];
#pragma unroll
    for (int k = 0; k < 5; ++k) { const int q = tid + 512 * k; it_l[k] = q / 40; it_cg[k] = q % 40; const int cg = it_cg[k]; it_col[k] = cg < 8 ? 64 * h + 8 * cg : cg < 24 ? 1024 + 128 * g + 8 * (cg - 8) : 1280 + 128 * g + 8 * (cg - 24); }
    v4u pf[5]; f32x4 dx = (f32x4){0.f, 0.f, 0.f, 0.f};
    auto issue_s1 = [&](int c) { const int id = c == 0 ? 1024 : b * 128 + c - 1;
#pragma unroll
        for (int k = 0; k < 5; ++k) { const int l = it_l[k]; pf[k] = (v4u){0u, 0u, 0u, 0u};
            if (c > 0 || l >= 48) { const bf16* src = l >= 61 ? SIDE + ((size_t)id * 3 + (l - 61)) * XBCW : XBC + (size_t)(c > 0 ? 64 * id + l : META0 + l - 48) * XBCW; pf[k] = *(const v4u*)(src + it_col[k]); } }
        if (wv == 0) dx = DTX[((size_t)id * 16 + h) * 64 + lane];
    };
    issue_s1(0);
    for (int c = 0; c < 129; ++c) {
#pragma unroll
        for (int k = 0; k < 5; ++k) { const int cg = it_cg[k], l = it_l[k]; const v4u w = pf[k];
            const unsigned short hv[8] = {(unsigned short)(w.x & 0xffff), (unsigned short)(w.x >> 16), (unsigned short)(w.y & 0xffff), (unsigned short)(w.y >> 16), (unsigned short)(w.z & 0xffff), (unsigned short)(w.z >> 16), (unsigned short)(w.w & 0xffff), (unsigned short)(w.w >> 16)};
            if (cg < 8) {
#pragma unroll
                for (int e = 0; e < 8; ++e) *(LAS unsigned short*)(L + SD_XT + sd_swz(8 * cg + e, l)) = hv[e]; }
            else if (cg < 24) { *(LAS v4u*)(L + SD_BM + l * 272 + (cg - 8) * 16) = w;
#pragma unroll
                for (int e = 0; e < 8; ++e) *(LAS unsigned short*)(L + SD_BT + sd_swz(8 * (cg - 8) + e, l)) = hv[e]; }
            else *(LAS v4u*)(L + SD_CM + l * 272 + (cg - 24) * 16) = w; }
        if (wv == 0) { *(LAS float*)(L + SD_DT + lane * 4) = dx[0]; *(LAS float*)(L + SD_ACS + lane * 4) = dx[1]; *(LAS float*)(L + SD_WGT + lane * 4) = dx[2]; *(LAS float*)(L + SD_EAC + lane * 4) = dx[3]; }
        if (c + 1 < 129) issue_s1(c + 1);
        const int el = tid >> 3, ep = (tid & 7) * 8, es = 64 * c - 48 + el; v4u zv = (v4u){0u, 0u, 0u, 0u};
        if (es >= 0) zv = *(const v4u*)(Z + (size_t)seq_row(b, es) * D + 64 * h + ep);
        WG_BAR();
        const float etot = *(const LAS float*)(L + SD_EAC + 63 * 4);
        { const int p = tid >> 3, s0 = (tid & 7) * 8; const v4u v = *(const LAS v4u*)(L + SD_XT + sd_swz(p, s0)); const LAS float* wg = (const LAS float*)(L + SD_WGT) + s0;
          v4u w; w.x = cvt_pk_bf16(bflo(v.x) * wg[0], bfhi(v.x) * wg[1]); w.y = cvt_pk_bf16(bflo(v.y) * wg[2], bfhi(v.y) * wg[3]); w.z = cvt_pk_bf16(bflo(v.z) * wg[4], bfhi(v.z) * wg[5]); w.w = cvt_pk_bf16(bflo(v.w) * wg[6], bfhi(v.w) * wg[7]);
          *(LAS v4u*)(L + SD_XWT + p * 144 + s0 * 2) = w; }
#pragma unroll
        for (int k = 0; k < 2; ++k) { const int id = 2 * wv + k, lt = id >> 2, stl = id & 3; f32x4 acc = (f32x4){0.f, 0.f, 0.f, 0.f};
            if (stl <= lt) {
#pragma unroll
                for (int ks = 0; ks < 4; ++ks) { const bf16x8 af = *(const LAS bf16x8*)(L + SD_CM + (16 * lt + fr) * 272 + (32 * ks + 8 * fq) * 2), bf = *(const LAS bf16x8*)(L + SD_BM + (16 * stl + fr) * 272 + (32 * ks + 8 * fq) * 2);
                    acc = __builtin_amdgcn_mfma_f32_16x16x32_bf16(af, bf, acc, 0, 0, 0); } }
            const int sidx = 16 * stl + fr, l0 = 16 * lt + 4 * fq; const float acs_s = *(const LAS float*)(L + SD_ACS + sidx * 4), dt_s = *(const LAS float*)(L + SD_DT + sidx * 4);
            const f32x4 acl = *(const LAS f32x4*)(L + SD_ACS + l0 * 4); float m[4];
#pragma unroll
            for (int r = 0; r < 4; ++r) m[r] = sidx <= l0 + r ? acc[r] * fast_exp(acl[r] - acs_s) * dt_s : 0.f;
            const unsigned u0 = cvt_pk_bf16(m[0], m[1]), u1 = cvt_pk_bf16(m[2], m[3]); LAS unsigned char* mp = L + SD_MM + l0 * 144 + sidx * 2;
            *(LAS unsigned short*)(mp) = (unsigned short)(u0 & 0xffffu); *(LAS unsigned short*)(mp + 144) = (unsigned short)(u0 >> 16); *(LAS unsigned short*)(mp + 288) = (unsigned short)(u1 & 0xffffu); *(LAS unsigned short*)(mp + 432) = (unsigned short)(u1 >> 16); }
        WG_BAR();
#pragma unroll
        for (int k = 0; k < 2; ++k) { const int id = 2 * wv + k, lt = id >> 2, pt = id & 3; f32x4 yd = (f32x4){0.f, 0.f, 0.f, 0.f}, yo = yd;
#pragma unroll
            for (int ks = 0; ks < 2; ++ks) { const bf16x8 af = *(const LAS bf16x8*)(L + SD_MM + (16 * lt + fr) * 144 + (32 * ks + 8 * fq) * 2), bf = *(const LAS bf16x8*)(L + SD_XT + sd_swz(16 * pt + fr, 32 * ks + 8 * fq));
                yd = __builtin_amdgcn_mfma_f32_16x16x32_bf16(af, bf, yd, 0, 0, 0); }
#pragma unroll
            for (int ks = 0; ks < 4; ++ks) { const bf16x8 af = *(const LAS bf16x8*)(L + SD_CM + (16 * lt + fr) * 272 + (32 * ks + 8 * fq) * 2), bf = *(const LAS bf16x8*)(L + SD_PS + (16 * pt + fr) * 272 + (32 * ks + 8 * fq) * 2);
                yo = __builtin_amdgcn_mfma_f32_16x16x32_bf16(af, bf, yo, 0, 0, 0); }
            const int p = 16 * pt + fr, l0 = 16 * lt + 4 * fq;
            const v2u xw = *(const LAS v2u*)(L + SD_XT + sd_swz(p, l0)); const f32x4 ea = *(const LAS f32x4*)(L + SD_EAC + l0 * 4);
            const float y0 = yd[0] + ea[0] * yo[0] + Dh * bflo(xw.x), y1 = yd[1] + ea[1] * yo[1] + Dh * bfhi(xw.x), y2 = yd[2] + ea[2] * yo[2] + Dh * bflo(xw.y), y3 = yd[3] + ea[3] * yo[3] + Dh * bfhi(xw.y);
            const unsigned u0 = cvt_pk_bf16(y0, y1), u1 = cvt_pk_bf16(y2, y3); LAS unsigned char* yp = L + SD_YT + l0 * 144 + p * 2;
            *(LAS unsigned short*)(yp) = (unsigned short)(u0 & 0xffffu); *(LAS unsigned short*)(yp + 144) = (unsigned short)(u0 >> 16); *(LAS unsigned short*)(yp + 288) = (unsigned short)(u1 & 0xffffu); *(LAS unsigned short*)(yp + 432) = (unsigned short)(u1 >> 16); }
#pragma unroll
        for (int pt = 0; pt < 4; ++pt) { f32x4 acc = st[pt] * etot;
#pragma unroll
            for (int ks = 0; ks < 2; ++ks) { const bf16x8 af = *(const LAS bf16x8*)(L + SD_BT + sd_swz(16 * wv + fr, 32 * ks + 8 * fq)), bf = *(const LAS bf16x8*)(L + SD_XWT + (16 * pt + fr) * 144 + (32 * ks + 8 * fq) * 2);
                acc = __builtin_amdgcn_mfma_f32_16x16x32_bf16(af, bf, acc, 0, 0, 0); }
            st[pt] = acc; }
        WG_BAR();
#pragma unroll
        for (int pt = 0; pt < 4; ++pt) { v2u w; w.x = cvt_pk_bf16(st[pt][0], st[pt][1]); w.y = cvt_pk_bf16(st[pt][2], st[pt][3]);
            *(LAS v2u*)(L + SD_PS + (16 * pt + fr) * 272 + (16 * wv + 4 * fq) * 2) = w; }
        if (es >= 0) { const v4u yv = *(const LAS v4u*)(L + SD_YT + el * 144 + ep * 2);
            v4u w; w.x = cvt_pk_bf16(bflo(yv.x) * siluf_(bflo(zv.x)), bfhi(yv.x) * siluf_(bfhi(zv.x))); w.y = cvt_pk_bf16(bflo(yv.y) * siluf_(bflo(zv.y)), bfhi(yv.y) * siluf_(bfhi(zv.y)));
            w.z = cvt_pk_bf16(bflo(yv.z) * siluf_(bflo(zv.z)), bfhi(yv.z) * siluf_(bfhi(zv.z))); w.w = cvt_pk_bf16(bflo(yv.w) * siluf_(bflo(zv.w)), bfhi(yv.w) * siluf_(bfhi(zv.w)));
            *(v4u*)(Y + (size_t)seq_row(b, es) * 2048 + 64 * h + ep) = w; }
    }
}
__device__ __forceinline__ void ssd_norm_phase(Frame& F) {
    const int gw = F.wi * NWAVES + F.wave, NGW = F.wn * NWAVES, lane = F.lane; bf16* Y = (bf16*)(F.ws + WS_Y); const float* nw = F.A->in[I_EV_SSM_NORM];
    v4u nx[2] = {(v4u){0u, 0u, 0u, 0u}, (v4u){0u, 0u, 0u, 0u}};
    if (gw < MV) { nx[0] = *(const v4u*)(Y + (size_t)gw * 2048 + 8 * lane); nx[1] = *(const v4u*)(Y + (size_t)gw * 2048 + 512 + 8 * lane); }
    for (int m = gw; m < MV; m += NGW) { const v4u cur[2] = {nx[0], nx[1]}; const int mn = m + NGW;
        if (mn < MV) { nx[0] = *(const v4u*)(Y + (size_t)mn * 2048 + 8 * lane); nx[1] = *(const v4u*)(Y + (size_t)mn * 2048 + 512 + 8 * lane); }
#pragma unroll
        for (int hlf = 0; hlf < 2; ++hlf) { bf16* p = Y + (size_t)m * 2048 + hlf * 512 + 8 * lane; const v4u a = cur[hlf];
            float v[8] = {bflo(a.x), bfhi(a.x), bflo(a.y), bfhi(a.y), bflo(a.z), bfhi(a.z), bflo(a.w), bfhi(a.w)}; float ss = 0.f;
#pragma unroll
            for (int e = 0; e < 8; ++e) ss += v[e] * v[e];
            const float sc = rsqrtf(wave_sum(ss) * (1.0f / 512.0f) + LN_EPS); const f32x4 n0 = *(const f32x4*)(nw + hlf * 512 + 8 * lane), n1 = *(const f32x4*)(nw + hlf * 512 + 8 * lane + 4);
            v4u w; w.x = cvt_pk_bf16(v[0] * sc * n0[0], v[1] * sc * n0[1]); w.y = cvt_pk_bf16(v[2] * sc * n0[2], v[3] * sc * n0[3]); w.z = cvt_pk_bf16(v[4] * sc * n1[0], v[5] * sc * n1[1]); w.w = cvt_pk_bf16(v[6] * sc * n1[2], v[7] * sc * n1[3]);
            *(v4u*)p = w; }
    }
}
__device__ __forceinline__ void group_barrier(unsigned* cnt, unsigned members, unsigned* bar) {
    asm volatile("s_waitcnt vmcnt(0)" ::: "memory");
    __syncthreads();
    if (threadIdx.x == 0) {
        __builtin_amdgcn_fence(__ATOMIC_RELEASE, "agent");
        asm volatile("s_waitcnt vmcnt(0)" ::: "memory");
        (void)xb_add(cnt, 1u);
        XB_SPIN(xb_ld(cnt) < members, bar);
        __builtin_amdgcn_fence(__ATOMIC_ACQUIRE, "agent");
        asm volatile("s_waitcnt vmcnt(0)" ::: "memory");
    }
    __syncthreads();
}
__device__ __forceinline__ void mixers_phase(Frame& F, unsigned* bar) {
    const int u = blockIdx.x;
    if (u < 128) rwkv_unit(F, u >> 4, u & 15);
    else if (u < 256) {
        F.wi = u - 128; F.wn = 128; ssd_conv_prepass(F); F.wi = blockIdx.x; F.wn = F.G;
        group_barrier((unsigned*)(F.ctl + CW_GRP), 128u, bar);
        ssd_unit(F, (u - 128) >> 4, (u - 128) & 15);
        __syncthreads();
        F.wi = u - 128; F.wn = 128; late_weights(F); expert_amax_phase<false>(F);
        group_barrier((unsigned*)(F.ctl + CW_GRP + 1), 128u, bar);
        ssd_norm_phase(F);
        convert_experts(F); convert_wgu8(F); F.wi = blockIdx.x; F.wn = F.G; }
}


template <bool DUAL, int KS  , class EpiS>
__device__ __forceinline__ void skinny_rows(Frame& F, const bf16* A16, int lda, int K, const bf16* Bt, int ntiles, const EpiS& E) {
    const int fr = F.lane & 15, fq = F.lane >> 4; LAS f32x4* part = (LAS f32x4*)F.lds;
    for (int tl = blockIdx.x; tl < ntiles; tl += F.G) {
        const int br0 = E.brow(tl), kw = F.wave * 32 * KS;
        const bf16* ap = A16 + (size_t)fr * lda + kw + 8 * fq; const bf16* bp = Bt + (size_t)(br0 + fr) * K + kw + 8 * fq; const bf16* bp2 = bp + (size_t)128 * K;
        bf16x8 a[KS], b[KS], b2[DUAL ? KS : 1];
#pragma unroll
        for (int s = 0; s < KS; ++s) { a[s] = *(const bf16x8*)(ap + 32 * s); b[s] = *(const bf16x8*)(bp + 32 * s); if (DUAL) b2[s] = *(const bf16x8*)(bp2 + 32 * s); }
        f32x4 acc = (f32x4){0.f, 0.f, 0.f, 0.f}, acc2 = acc;
#pragma unroll
        for (int s = 0; s < KS; ++s) { acc = __builtin_amdgcn_mfma_f32_16x16x32_bf16(a[s], b[s], acc, 0, 0, 0); if (DUAL) acc2 = __builtin_amdgcn_mfma_f32_16x16x32_bf16(a[s], b2[s], acc2, 0, 0, 0); }
        __syncthreads();
        part[F.wave * 64 + F.lane] = acc; if (DUAL) part[512 + F.wave * 64 + F.lane] = acc2;
        __syncthreads();
        if (F.wave == 0) {
            acc = part[F.lane]; if (DUAL) acc2 = part[512 + F.lane];
#pragma unroll
            for (int w = 1; w < 8; ++w) { acc += part[w * 64 + F.lane]; if (DUAL) acc2 += part[512 + w * 64 + F.lane]; }
            E(tl, acc, acc2, fr, fq);
        }
    }
    __syncthreads();
}
struct SkIn0 { bf16* Z; bf16* XBC; bf16* COLS; float* DT;
    __device__ __forceinline__ int brow(int tl) const { return 16 * tl; }
    __device__ __forceinline__ void operator()(int tl, const f32x4& acc, const f32x4&, int fr, int fq) const { const int c = 16 * tl + fr;
#pragma unroll
        for (int r = 0; r < 4; ++r) { const size_t row = META0 + 4 * fq + r;
            if (c < 1024) Z[row * 1024 + c] = (bf16)f2bf(acc[r]); else if (c < 2560) XBC[row * XBCW + c - 1024] = (bf16)f2bf(acc[r]); else if (c < 5888) COLS[row * COLSW + c - 2560] = (bf16)f2bf(acc[r]); else DT[row * 16 + c - 5888] = acc[r]; } } };
struct SkResid { const bf16* Hres; bf16* S;
    __device__ __forceinline__ int brow(int tl) const { return 16 * tl; }
    __device__ __forceinline__ void operator()(int tl, const f32x4& acc, const f32x4&, int fr, int fq) const { const int c = 16 * tl + fr;
#pragma unroll
        for (int r = 0; r < 4; ++r) { const size_t o = (size_t)(META0 + 4 * fq + r) * 1024 + c; S[o] = (bf16)f2bf(ALPHA * bf2f(Hres[o]) + acc[r]); } } };
struct SkSwiglu { bf16* ACT;
    __device__ __forceinline__ int brow(int tl) const { const int j0 = 16 * tl; return 256 * (j0 >> 7) + (j0 & 127); }
    __device__ __forceinline__ void operator()(int tl, const f32x4& g, const f32x4& u, int fr, int fq) const {
#pragma unroll
        for (int r = 0; r < 4; ++r) ACT[(size_t)(META0 + 4 * fq + r) * DFF + 16 * tl + fr] = (bf16)f2bf(siluf_(g[r]) * u[r]); } };
struct SkIn1 { bf16* G1; bf16* XR;
    __device__ __forceinline__ int brow(int tl) const { return 16 * tl; }
    __device__ __forceinline__ void operator()(int tl, const f32x4& acc, const f32x4&, int fr, int fq) const { const int c = 16 * tl + fr;
#pragma unroll
        for (int r = 0; r < 4; ++r) { const size_t row = META0 + 4 * fq + r; if (c < 1024) G1[row * 1024 + c] = (bf16)f2bf(gelu_tanh(acc[r])); else XR[row * 1024 + c - 1024] = (bf16)f2bf(acc[r]); } } };

template <int SLEEP  > __device__ __forceinline__ void stagger(Frame&) {
    const int r = (blockIdx.x >> 3) & 31;
    if (false) for (int i = 0; i < r; ++i) __builtin_amdgcn_s_sleep(SLEEP);
}

constexpr int N_PHASES = 24;
__global__ void __launch_bounds__(NTHR, 2) mega_fwd(Args args) {
    extern __shared__ __attribute__((aligned(16))) unsigned char lds[];
    Frame F;
    F.lds = (LAS unsigned char*)lds;
    F.MISC = (volatile LAS unsigned*)(F.lds + MISC_OFF);
    F.tid = threadIdx.x; F.lane = F.tid & 63; F.wave = __builtin_amdgcn_readfirstlane(F.tid >> 6); F.G = gridDim.x; F.wi = blockIdx.x; F.wn = gridDim.x;
    F.ws = args.ws; F.dout = (unsigned char*)args.out; F.ctl = (gu32*)(args.ws + WS_CTL);
    F.A = &args;
    for (int u = F.tid; u < (LDS_BYTES - LDSCTL_OFF) / 4; u += NTHR) ((LAS unsigned*)(F.lds + LDSCTL_OFF))[u] = 0u;
    __syncthreads();
    const int lo = args.ph_lo, hi = args.ph_hi;
    const bool multi = (hi - lo) > 1;
    XcdBarrier bar; bar.bar = (unsigned*)(F.ctl + CW_BAR); bar.x = 0; bar.st = nullptr;
    if (multi) bar = xcd_barrier_post((unsigned*)(F.ctl + CW_BAR), F.MISC + 8);
#define IN(k) (lo <= (k) && (k) < hi)
#define SEAM(k) do { if (IN(k) && IN((k) + 1)) xcd_barrier(bar); } while (0)
    bf16* H = (bf16*)(F.ws + WS_H);
    bf16* S = (bf16*)(F.dout + DO_Z);
    bf16* Y = (bf16*)(F.ws + WS_Y);

    if (IN(0)) { p0_prologue(F); expert_amax_phase<true>(F); } SEAM(0);
    if (IN(1)) {
        convert_win8(F); xcd_barrier(bar);
        stagger<16>(F);
        pg8::Gemm g{(const bf16*)(F.ws + WS_H80), (const bf16*)(F.dout + DO_WIN8), D / 2, D / 2}; pg8::StaticOrder so; so.init(MX / 256, IN0_N / 256, F.G, (int)blockIdx.x);
        EpiIn0I8 E{(bf16*)(F.dout + DO_Z), (bf16*)(F.ws + WS_XBC), (bf16*)(F.ws + WS_COLS), (float*)(F.ws + WS_DT), (const float*)(F.ws + WS_SROW), (const unsigned*)(F.ctl + CW_EAMAX + 9), {}};
        pg8::gemm_phase<EpiIn0I8, pg8::StaticOrder, true, true, true>(F.lds, g, so, E);
        skinny_rows<false, 4>(F, H + (size_t)META0 * D, D, D, (const bf16*)(F.dout + DO_WINT), 369, SkIn0{E.Z, E.XBC, E.COLS, E.DT});
    } SEAM(1);
    if (IN(2)) { rwkv_lin_phase(F); xcd_barrier(bar); mixers_phase(F, bar.bar); } SEAM(2);
    if (IN(4)) {
        pg8::Gemm g{Y, (const bf16*)(F.dout + DO_WOUTT), 2048, 2048}; pg8::StaticOrder so; so.init(MX / 256, 4, F.G, (int)blockIdx.x);
        EpiResid E{H, S};
        pg8::gemm_phase<EpiResid, pg8::StaticOrder, true, true>(F.lds, g, so, E);
        skinny_rows<false, 8>(F, Y + (size_t)META0 * 2048, 2048, 2048, (const bf16*)(F.dout + DO_WOUTT), 64, SkResid{H, S});
    } SEAM(4);
    if (IN(5)) { ln_phase<true>(F, S, H, F.A->in[I_EV_LN1_G], F.A->in[I_EV_LN1_B]); } SEAM(5);
    if (IN(6)) {
        stagger<16>(F);
        pg8::Gemm g{(const bf16*)(F.ws + WS_H80), (const bf16*)(F.dout + DO_WGU8), D / 2, D / 2}; pg8::StaticOrder so; so.init(MX / 256, 2 * DFF / 256, F.G, (int)blockIdx.x);
        EpiSwigluI8<true> E{(void*)(F.ws + WS_ACT0), 0, (const float*)(F.ws + WS_SROW), nullptr, (const unsigned*)(F.ctl + CW_EAMAX + 8), {}};
        pg8::gemm_phase<EpiSwigluI8<true>, pg8::StaticOrder, true, true, true>(F.lds, g, so, E);
        skinny_rows<true, 4>(F, H + (size_t)META0 * D, D, D, (const bf16*)(F.dout + DO_WGUT), DFF / 16, SkSwiglu{(bf16*)(F.ws + WS_ACT0)});
    } SEAM(6);
    if (IN(7)) {
        pg8::Gemm g{(const bf16*)(F.ws + WS_ACT0), (const bf16*)(F.dout + DO_WDN8), DFF / 2, DFF / 2}; pg8::StaticOrder so; so.init(MX / 256, 4, F.G, (int)blockIdx.x);
        EpiResidI8 E{H, S, (const unsigned*)(F.ctl + CW_EAMAX + 10), 0.f};
        pg8::gemm_phase<EpiResidI8, pg8::StaticOrder, true, true, true>(F.lds, g, so, E);
        skinny_rows<false, 11>(F, (const bf16*)(F.ws + WS_ACT0) + (size_t)META0 * DFF, DFF, DFF, (const bf16*)(F.dout + DO_WDNT), 64, SkResid{H, S});
    } SEAM(7);
    if (IN(8)) { ln_phase<true>(F, S, H, F.A->in[I_EV_LN2_G], F.A->in[I_EV_LN2_B], WS_H81); } SEAM(8);
    if (IN(9)) {
        pg8::Gemm g{(const bf16*)(F.ws + WS_H81), (const bf16*)(F.dout + DO_WIN18), D / 2, D / 2}; pg8::StaticOrder so; so.init(MX / 256, 8, F.G, (int)blockIdx.x);
        EpiIn1I8 E{(bf16*)(F.ws + WS_G1), (bf16*)(F.ws + WS_XR), (const float*)(F.ws + WS_SROW), (const unsigned*)(F.ctl + CW_EAMAX + 11), {}};
        pg8::gemm_phase<EpiIn1I8, pg8::StaticOrder, true, true, true>(F.lds, g, so, E);
        skinny_rows<false, 4>(F, H + (size_t)META0 * D, D, D, (const bf16*)(F.ws + WS_WIN1T), 128, SkIn1{E.G1, E.XR});
    } SEAM(9);
    if (IN(10)) { lru_gates_phase(F); } SEAM(10);
    if (IN(11)) { lru_carry_phase(F); } SEAM(11);
    if (IN(12)) { lru_fix_phase(F); } SEAM(12);
    if (IN(13)) {
        pg8::Gemm g{(const bf16*)(F.ws + WS_U), (const bf16*)(F.ws + WS_WOUT1T), D, D}; pg8::StaticOrder so; so.init(MX / 256, 4, F.G, (int)blockIdx.x);
        EpiResid E{H, S};
        pg8::gemm_phase<EpiResid, pg8::StaticOrder, true, true>(F.lds, g, so, E);
        skinny_rows<false, 4>(F, (const bf16*)(F.ws + WS_U) + (size_t)META0 * D, D, D, (const bf16*)(F.ws + WS_WOUT1T), 64, SkResid{H, S});
    } SEAM(13);
    if (IN(14)) { ln_router_phase(F, S, H); } SEAM(14);
    if (IN(15)) { moe_dispatch_phase(F); } SEAM(15);
#define MOE_CHUNK_PHASES(q, pa, pb) \
    if (IN(pa)) { stagger<14>(F); int off[9]; const int ntiles = moe_offsets(F, off); const int t0 = (q) * 256; int nM = ntiles - t0; nM = nM < 0 ? 0 : (((q) == 0 && nM > 256) ? 256 : nM);     \
        pg8::Gemm g{(const bf16*)(F.ws + WS_XG), (const bf16*)(F.ws + WS_WEGU), D / 2, D / 2}; MoeOrder mo; _Pragma("unroll") for (int k = 0; k < 7; ++k) mo.toff[k] = off[k + 1] >> 8; mo.t0 = t0; mo.nbt = 2 * DFF / 256; mo.so.init(nM, 2 * DFF / 256, F.G, (int)blockIdx.x); \
        EpiSwigluI8<true> E{(void*)(F.ws + WS_ACTM), t0 * 256, (const float*)(F.ws + WS_SSLOT), (const int*)(F.ws + WS_TILEE), (const unsigned*)(F.ctl + CW_EAMAX), {}}; \
        pg8::gemm_phase<EpiSwigluI8<true>, MoeOrder, true, true, true>(F.lds, g, mo, E); } SEAM(pa); \
    if (IN(pb)) { int off[9]; const int ntiles = moe_offsets(F, off); const int t0 = (q) * 256; int nM = ntiles - t0; nM = nM < 0 ? 0 : (((q) == 0 && nM > 256) ? 256 : nM);     \
        pg8::Gemm g{(const bf16*)((const unsigned char*)(F.ws + WS_ACTM) - (size_t)t0 * 256 * DFF), (const bf16*)(F.ws + WS_WEDN), DFF / 2, DFF / 2}; MoeOrder mo; _Pragma("unroll") for (int k = 0; k < 7; ++k) mo.toff[k] = off[k + 1] >> 8; mo.t0 = t0; mo.nbt = 4; mo.so.init(nM, 4, F.G, (int)blockIdx.x); \
        EpiPlainI8 E{(bf16*)(F.ws + WS_YSLOT), (const int*)(F.ws + WS_TILEE), (const unsigned*)(F.ctl + CW_EAMAX + 16), 0.f}; \
        pg8::gemm_phase<EpiPlainI8, MoeOrder, true, true, true>(F.lds, g, mo, E); } SEAM(pb);
    MOE_CHUNK_PHASES(0, 17, 18)
    MOE_CHUNK_PHASES(1, 19, 20)
    if (IN(23)) { final_phase(F, H, F.A->in[I_OD_LN2_G], F.A->in[I_OD_LN2_B], args.out); }
#undef IN
#undef SEAM
}

#ifndef MK_PER_PHASE
#define MK_PER_PHASE 0
#endif
extern "C" void kernel_launch(void* const* d_in, const int* in_sizes, int n_in, void* d_out, int out_size, void* d_ws, size_t ws_size, hipStream_t stream) {
    static int grid = 0;
    if (grid == 0) {
        if (n_in != 43 || in_sizes[0] != MX * D || out_size != MX * D || ws_size < WS_END) { fprintf(stderr, "kernel_launch: unexpected shapes: n_in %d in0 %d out %d ws %zu\n", n_in, n_in > 0 ? in_sizes[0] : -1, out_size, ws_size); grid = -1; return; }
        int dev = 0, cus = 0, per_cu = 0;
        if (hipGetDevice(&dev) != hipSuccess || hipDeviceGetAttribute(&cus, hipDeviceAttributeMultiprocessorCount, dev) != hipSuccess) { grid = -1; return; }
        if (hipFuncSetAttribute((const void*)mega_fwd, hipFuncAttributeMaxDynamicSharedMemorySize, LDS_BYTES) != hipSuccess) { fprintf(stderr, "kernel_launch: hipFuncSetAttribute failed\n"); grid = -1; return; }
        if (hipOccupancyMaxActiveBlocksPerMultiprocessor(&per_cu, (const void*)mega_fwd, NTHR, LDS_BYTES) != hipSuccess || per_cu < 1) { fprintf(stderr, "kernel_launch: occupancy query says %d\n", per_cu); }
        (void)hipGetLastError();
        grid = cus;
    }
    if (grid < 0) return;
    if (hipMemsetAsync((char*)d_ws + WS_CTL, 0, CTL_ZERO_BYTES, stream) != hipSuccess) return;
    Args a{};
    for (int i = 0; i < 43; ++i) a.in[i] = (const float*)d_in[i];
    a.out = (float*)d_out; a.ws = (unsigned char*)d_ws;
#if MK_PER_PHASE
    for (int p = 0; p < N_PHASES; ++p) { a.ph_lo = p; a.ph_hi = p + 1; hipLaunchKernelGGL(mega_fwd, dim3(grid), dim3(NTHR), LDS_BYTES, stream, a); }
#else
    a.ph_lo = 0; a.ph_hi = N_PHASES;
    hipLaunchKernelGGL(mega_fwd, dim3(grid), dim3(NTHR), LDS_BYTES, stream, a);
#endif
}
```

```cpp
#include <hip/hip_runtime.h>
#include <cstdio>
#include <cstdint>

#define GAS __attribute__((address_space(1)))
#define LAS __attribute__((address_space(3)))
typedef unsigned short bf16;
typedef unsigned v4u __attribute__((ext_vector_type(4)));
typedef unsigned v2u __attribute__((ext_vector_type(2)));
typedef float f32x4 __attribute__((ext_vector_type(4)));
typedef float f32x2 __attribute__((ext_vector_type(2)));
typedef short bf16x8 __attribute__((ext_vector_type(8)));
typedef GAS unsigned gu32;
#define RLX_AGENT __ATOMIC_RELAXED, __HIP_MEMORY_SCOPE_AGENT
#define LDS_WAIT() asm volatile("s_waitcnt lgkmcnt(0)" ::: "memory")
#define VM_WAIT() asm volatile("s_waitcnt vmcnt(0)" ::: "memory")
__device__ __forceinline__ unsigned f2bf(float f) { unsigned u = __builtin_bit_cast(unsigned, f); return (u + 0x7fffu + ((u >> 16) & 1u)) >> 16; }
__device__ __forceinline__ unsigned pk2(float lo, float hi) { return f2bf(lo) | (f2bf(hi) << 16); }
typedef __bf16 bf16x2_t __attribute__((ext_vector_type(2)));
__device__ __forceinline__ unsigned cvt_pk_bf16(float lo, float hi) { const f32x2 v = {lo, hi}; return __builtin_bit_cast(unsigned, __builtin_convertvector(v, bf16x2_t)); }
__device__ __forceinline__ float bflo(unsigned w) { return __builtin_bit_cast(float, w << 16); }
__device__ __forceinline__ float bfhi(unsigned w) { return __builtin_bit_cast(float, w & 0xffff0000u); }
__device__ __forceinline__ float bf2f(bf16 h) { return __builtin_bit_cast(float, (unsigned)h << 16); }
__device__ __forceinline__ float fast_rcp(float x) { return __builtin_amdgcn_rcpf(x); }
__device__ __forceinline__ float fast_exp(float x) { return __builtin_amdgcn_exp2f(x * 1.4426950408889634f); }
__device__ __forceinline__ float sigmoidf_(float x) { return fast_rcp(1.0f + fast_exp(-x)); }
__device__ __forceinline__ float siluf_(float x) { return x * sigmoidf_(x); }
__device__ __forceinline__ float softplusf_(float x) { return x > 20.f ? x : log1pf(fast_exp(x)); }
#define DPPF(x, ctrl) __builtin_bit_cast(float, __builtin_amdgcn_update_dpp(0, __builtin_bit_cast(int, (x)), (ctrl), 0xF, 0xF, false))
__device__ __forceinline__ float wave_sum(float v) {
    v += DPPF(v, 0xB1); v += DPPF(v, 0x4E); v += DPPF(v, 0x141); v += DPPF(v, 0x140);
    const int b = __builtin_bit_cast(int, v);
    return (__builtin_bit_cast(float, __builtin_amdgcn_readlane(b, 0)) + __builtin_bit_cast(float, __builtin_amdgcn_readlane(b, 16))) + (__builtin_bit_cast(float, __builtin_amdgcn_readlane(b, 32)) + __builtin_bit_cast(float, __builtin_amdgcn_readlane(b, 48)));
}
__device__ __forceinline__ float wave_max(float v) {
    v = fmaxf(v, DPPF(v, 0xB1)); v = fmaxf(v, DPPF(v, 0x4E)); v = fmaxf(v, DPPF(v, 0x141)); v = fmaxf(v, DPPF(v, 0x140));
    const int b = __builtin_bit_cast(int, v);
    return fmaxf(fmaxf(__builtin_bit_cast(float, __builtin_amdgcn_readlane(b, 0)), __builtin_bit_cast(float, __builtin_amdgcn_readlane(b, 16))), fmaxf(__builtin_bit_cast(float, __builtin_amdgcn_readlane(b, 32)), __builtin_bit_cast(float, __builtin_amdgcn_readlane(b, 48))));
}

namespace pg8 {
#define PG8_LAS __attribute__((address_space(3)))
typedef unsigned short bf16_t;
typedef short bf16x8 __attribute__((ext_vector_type(8)));
typedef float f32x4 __attribute__((ext_vector_type(4)));
typedef unsigned u32x4 __attribute__((ext_vector_type(4)));
constexpr int BM = 256, BK = 64, HALF = 128, HTB = HALF * BK * 2  , STAGE_BYTES = 8 * HTB, NXCD = 8, WGM = 8;

__host__ __device__ __forceinline__ int lds_byte(int r, int c) { const int st = (r >> 4) * 2 + (c >> 5), rr = r & 15, cc = c & 31, ob = rr * 64 + cc * 2; return st * 1024 + (ob ^ (((ob >> 9) & 1) << 5)); }
__host__ __device__ __forceinline__ void stage_rc(int b, int& R, int& C) { const int st = b / 1024, sb = b % 1024, swz = sb ^ (((sb >> 9) & 1) << 5); R = (st >> 1) * 16 + swz / 64; C = (st & 1) * 32 + (swz % 64) / 2; }
__host__ __device__ __forceinline__ int perm32(int rho) { const int n = rho >> 4, i = rho & 15; return 8 * (i >> 2) + 4 * n + (i & 3); }

struct Unit { int pm, pn, pb, pe; };
struct Gemm { const bf16_t* A; const bf16_t* Bt; int lda, K; };

struct StaticOrder {
    int nM, nN, nwg, G, c;
    __host__ __device__ void init(int nM_, int nN_, int G_, int c_) { nM = nM_; nN = nN_; nwg = nM * nN; G = G_; c = c_; }
    __host__ __device__ bool next(int i, Unit& u) const {
        const long L = (long)i * G + c; if (L >= nwg) return false;
        int wgid = (int)L; { const int q = nwg / NXCD, r = nwg % NXCD, xcd = wgid % NXCD, off = wgid / NXCD; wgid = (xcd < r ? xcd * (q + 1) : r * (q + 1) + (xcd - r) * q) + off; }
        const int nig = WGM * nN, gid = wgid / nig, fm = gid * WGM, gsz = (nM - fm) < WGM ? (nM - fm) : WGM;
        u.pm = fm + ((wgid % nig) % gsz); u.pn = (wgid % nig) / gsz; u.pb = u.pn; u.pe = 0; return true;
    }
    __device__ __forceinline__ void a_ready(const Unit&) const {}
    __device__ __forceinline__ void done(const Unit&) const {}
};
typedef int i32x4 __attribute__((ext_vector_type(4)));
template <bool I8> struct AccSel { typedef f32x4 T; };
template <> struct AccSel<true> { typedef i32x4 T; };
template <bool I8> __device__ __forceinline__ typename AccSel<I8>::T mma16(bf16x8 b, bf16x8 a, typename AccSel<I8>::T c) {
    if constexpr (I8) return __builtin_amdgcn_mfma_i32_16x16x64_i8(__builtin_bit_cast(i32x4, b), __builtin_bit_cast(i32x4, a), c, 0, 0, 0);
    else return __builtin_amdgcn_mfma_f32_16x16x32_bf16(b, a, c, 0, 0, 0);
}
template <class Epi, class Sched, bool ALIGN_EPI = false, bool SP2 = false, bool I8 = false>
__device__ __forceinline__ void gemm_phase(PG8_LAS unsigned char* lds, const Gemm g, const Sched& S, const Epi& E) {
    const int tid = threadIdx.x, wid = __builtin_amdgcn_readfirstlane(tid >> 6), lane = tid & 63, wr = wid >> 2, wc = wid & 3, fr = lane & 15, fq = lane >> 4;
    const int K = g.K, nt = K / BK;
    unsigned voffA[2], voffB[2];
#pragma unroll
    for (int i = 0; i < 2; ++i) { int R, C; stage_rc(tid * 16 + i * 8192, R, C); const int Rb = Epi::PERM ? ((R & ~31) + perm32(R & 31)) : R;
        voffA[i] = (unsigned)(R * g.lda + C) * 2u; voffB[i] = (unsigned)(Rb * K + C) * 2u; }
    const size_t kstep = (size_t)(BK * 2);
    const size_t hstepA = (size_t)HALF * g.lda * 2, hstepB = (size_t)HALF * K * 2;
    const size_t tstepA = 2 * hstepA, tstepB = 2 * hstepB;
    const unsigned ldsw = (unsigned)wid * 1024u;
    const int aoff = lds_byte(wr * 64 + fr, fq * 8), boff = lds_byte(wc * 32 + fr, fq * 8);
#define PG8_SA(b, h) (((b) * 2 + (h)) * HTB)
#define PG8_SB(b, h) ((4 + (b) * 2 + (h)) * HTB)
#define PG8_STAGE(bufoff, gbase, voff) do { _Pragma("unroll") for (int _i = 0; _i < 2; ++_i) \
        __builtin_amdgcn_global_load_lds((const unsigned*)((const char*)(gbase) + (voff)[_i]), (PG8_LAS unsigned*)(lds + (bufoff) + ldsw + _i * 8192), 16, 0, 0); } while (0)
#define PG8_LDA(dst, b, h) do { _Pragma("unroll") for (int m = 0; m < 4; ++m) _Pragma("unroll") for (int k = 0; k < 2; ++k) dst[m][k] = *(const PG8_LAS bf16x8*)(lds + PG8_SA(b, h) + aoff + m * 2048 + k * 1024); } while (0)
#define PG8_LDB(dst, b, h) do { _Pragma("unroll") for (int n = 0; n < 2; ++n) _Pragma("unroll") for (int k = 0; k < 2; ++k) dst[n][k] = *(const PG8_LAS bf16x8*)(lds + PG8_SB(b, h) + boff + n * 2048 + k * 1024); } while (0)
#define PG8_MMA(ai, bj, At, Bt) do { __builtin_amdgcn_s_setprio(1); _Pragma("unroll") for (int m = 0; m < 4; ++m) _Pragma("unroll") for (int n = 0; n < 2; ++n) _Pragma("unroll") for (int k = 0; k < 2; ++k) \
        acc[ai][bj][m][n] = mma16<I8>(Bt[n][k], At[m][k], acc[ai][bj][m][n]); __builtin_amdgcn_s_setprio(0); } while (0)
#define PG8_WAIT_V(n) asm volatile("s_waitcnt vmcnt(" #n ")" ::: "memory")
#define PG8_WAIT_L(n) asm volatile("s_waitcnt lgkmcnt(" #n ")" ::: "memory")
#define PG8_BAR __builtin_amdgcn_s_barrier()
#define PG8_SCHED __builtin_amdgcn_sched_barrier(0)
    Unit cur, nxt; int ui = 0;
    if (!S.next(0, cur)) return;
    typedef typename AccSel<I8>::T AccT;
    AccT acc[2][2][4][2];
#pragma unroll
    for (int a = 0; a < 2; ++a)
#pragma unroll
        for (int b = 0; b < 2; ++b)
#pragma unroll
            for (int m = 0; m < 4; ++m)
#pragma unroll
                for (int n = 0; n < 2; ++n) acc[a][b][m][n] = (AccT){0, 0, 0, 0};
    bf16x8 At[4][2], B0[2][2], B1[2][2];
    const char* cA = (const char*)g.A + (size_t)cur.pm * tstepA; const char* cB = (const char*)g.Bt + (size_t)cur.pb * tstepB;
    Epi Em = E;
    if constexpr (Epi::PREFETCH) Em.prefetch(cur, wr, wc, fr, fq);
    S.a_ready(cur);
    if constexpr (SP2) {
        PG8_STAGE(PG8_SB(0, 0), cB, voffB); PG8_STAGE(PG8_SB(0, 1), cB + hstepB, voffB); PG8_STAGE(PG8_SA(0, 0), cA, voffA); PG8_STAGE(PG8_SA(0, 1), cA + hstepA, voffA);
        if (wr == 1) PG8_BAR;
        PG8_WAIT_V(2); PG8_BAR;
        PG8_STAGE(PG8_SB(1, 0), cB + kstep, voffB); PG8_STAGE(PG8_SA(1, 0), cA + kstep, voffA); PG8_STAGE(PG8_SB(1, 1), cB + hstepB + kstep, voffB);
        PG8_WAIT_V(6); PG8_BAR;
    } else {
        PG8_STAGE(PG8_SB(0, 0), cB, voffB); PG8_STAGE(PG8_SA(0, 0), cA, voffA); PG8_STAGE(PG8_SB(0, 1), cB + hstepB, voffB); PG8_STAGE(PG8_SA(0, 1), cA + hstepA, voffA);
        if (wr == 1) PG8_BAR;
        PG8_WAIT_V(4); PG8_BAR;
        PG8_STAGE(PG8_SB(1, 0), cB + kstep, voffB); PG8_STAGE(PG8_SA(1, 0), cA + kstep, voffA); PG8_STAGE(PG8_SB(1, 1), cB + hstepB + kstep, voffB);
        PG8_WAIT_V(6); PG8_BAR;
    }
    for (;;) {
        const bool has_next = S.next(ui + 1, nxt);
        const char* nA = has_next ? (const char*)g.A + (size_t)nxt.pm * tstepA : cA; const char* nB = has_next ? (const char*)g.Bt + (size_t)nxt.pb * tstepB : cB;
        for (int t = 0; t < nt; t += 2) {
            const bool last = (t == nt - 2);
            const char* a1 = cA + (size_t)(t + 1) * kstep;
            const char* a2 = last ? nA : cA + (size_t)(t + 2) * kstep; const char* b2 = last ? nB : cB + (size_t)(t + 2) * kstep;
            const char* a3 = a2 + kstep; const char* b3 = b2 + kstep;
            if (last && has_next) S.a_ready(nxt);
            if constexpr (SP2) {
            PG8_LDB(B0, 0, 0); PG8_LDB(B1, 0, 1); PG8_SCHED; PG8_LDA(At, 0, 0); PG8_STAGE(PG8_SA(1, 1), a1 + hstepA, voffA);
            PG8_WAIT_V(8); PG8_WAIT_L(0); PG8_BAR; PG8_MMA(0, 0, At, B0); PG8_MMA(0, 1, At, B1); PG8_BAR; PG8_SCHED;
            PG8_LDA(At, 0, 1); PG8_STAGE(PG8_SB(0, 0), b2, voffB); PG8_STAGE(PG8_SB(0, 1), b2 + hstepB, voffB); PG8_STAGE(PG8_SA(0, 0), a2, voffA);
            PG8_WAIT_V(8); PG8_WAIT_L(0); PG8_BAR; PG8_MMA(1, 0, At, B0); PG8_MMA(1, 1, At, B1); PG8_BAR; PG8_SCHED;
            PG8_LDB(B0, 1, 0); PG8_LDB(B1, 1, 1); PG8_SCHED; PG8_LDA(At, 1, 0); PG8_STAGE(PG8_SA(0, 1), a2 + hstepA, voffA);
            PG8_WAIT_V(8); PG8_WAIT_L(0); PG8_BAR; PG8_MMA(0, 0, At, B0); PG8_MMA(0, 1, At, B1); PG8_BAR; PG8_SCHED;
            PG8_LDA(At, 1, 1); PG8_STAGE(PG8_SB(1, 0), b3, voffB); PG8_STAGE(PG8_SB(1, 1), b3 + hstepB, voffB); PG8_STAGE(PG8_SA(1, 0), a3, voffA);
            PG8_WAIT_V(8); PG8_WAIT_L(0); PG8_BAR; PG8_MMA(1, 0, At, B0); PG8_MMA(1, 1, At, B1); PG8_BAR; PG8_SCHED;
            } else {
            PG8_LDB(B0, 0, 0); PG8_SCHED; PG8_LDA(At, 0, 0); PG8_STAGE(PG8_SA(1, 1), a1 + hstepA, voffA);
            PG8_WAIT_L(8); PG8_BAR; PG8_WAIT_L(0); PG8_MMA(0, 0, At, B0); PG8_BAR; PG8_SCHED;
            PG8_LDB(B1, 0, 1); PG8_STAGE(PG8_SB(0, 0), b2, voffB);
            PG8_BAR; PG8_WAIT_L(0); PG8_MMA(0, 1, At, B1); PG8_BAR;
            PG8_LDA(At, 0, 1); PG8_STAGE(PG8_SA(0, 0), a2, voffA);
            PG8_BAR; PG8_WAIT_L(0); PG8_MMA(1, 0, At, B0); PG8_BAR; PG8_SCHED;
            PG8_STAGE(PG8_SB(0, 1), b2 + hstepB, voffB);
            PG8_WAIT_V(6); PG8_BAR; PG8_MMA(1, 1, At, B1); PG8_BAR;
            PG8_LDB(B0, 1, 0); PG8_SCHED; PG8_LDA(At, 1, 0); PG8_STAGE(PG8_SA(0, 1), a2 + hstepA, voffA);
            PG8_WAIT_L(8); PG8_BAR; PG8_WAIT_L(0); PG8_MMA(0, 0, At, B0); PG8_BAR; PG8_SCHED;
            PG8_LDB(B1, 1, 1); PG8_STAGE(PG8_SB(1, 0), b3, voffB);
            PG8_BAR; PG8_WAIT_L(0); PG8_MMA(0, 1, At, B1); PG8_BAR;
            PG8_LDA(At, 1, 1); PG8_STAGE(PG8_SA(1, 0), a3, voffA);
            PG8_BAR; PG8_WAIT_L(0); PG8_MMA(1, 0, At, B0); PG8_BAR; PG8_SCHED;
            PG8_STAGE(PG8_SB(1, 1), b3 + hstepB, voffB);
            PG8_WAIT_V(6); PG8_BAR; PG8_MMA(1, 1, At, B1); PG8_BAR;
            }
        }
        if constexpr (ALIGN_EPI) { if (wr == 0) PG8_BAR; }
        if constexpr (!Epi::AFTER_DRAIN) { Em(acc, cur, wr, wc, fr, fq); S.done(cur); }
        if (!has_next) break;
#pragma unroll
        for (int a = 0; a < 2; ++a)
#pragma unroll
            for (int b = 0; b < 2; ++b)
#pragma unroll
                for (int m = 0; m < 4; ++m)
#pragma unroll
                    for (int n = 0; n < 2; ++n) acc[a][b][m][n] = (AccT){0, 0, 0, 0};
        cur = nxt; cA = nA; cB = nB; ++ui;
        if constexpr (Epi::PREFETCH) Em.prefetch(cur, wr, wc, fr, fq);
        if constexpr (ALIGN_EPI) { if (wr == 1) PG8_BAR; }
    }
    PG8_WAIT_V(0);
    if constexpr (!ALIGN_EPI) { if (wr == 0) PG8_BAR; }
    PG8_BAR;
    if constexpr (Epi::AFTER_DRAIN) { E.fused(acc, cur, wr, wc, fr, fq, lds, wid, lane); S.done(cur); }
#undef PG8_SA
#undef PG8_SB
#undef PG8_STAGE
#undef PG8_LDA
#undef PG8_LDB
#undef PG8_MMA
#undef PG8_WAIT_V
#undef PG8_WAIT_L
#undef PG8_BAR
#undef PG8_SCHED
}
}

#define XB_TMO      128
#define XB_XCNT(j)  (256  + 64 * (j))
#define XB_XSUB(j)  (1280 + 64 * (j))
#define XB_XGEN(j)  (2304 + 64 * (j))
#define XB_TOP      3328
#define XB_TOPGEN   3392
#define XCD_BAR_WORDS 3456
#define XB_SPIN_CAP (1u << 18)

__device__ __forceinline__ unsigned xb_ld(unsigned* p)              { return __hip_atomic_load(p, __ATOMIC_RELAXED, __HIP_MEMORY_SCOPE_AGENT); }
__device__ __forceinline__ unsigned xb_add(unsigned* p, unsigned v) { return __hip_atomic_fetch_add(p, v, __ATOMIC_RELAXED, __HIP_MEMORY_SCOPE_AGENT); }
__device__ __forceinline__ unsigned xb_xcc_id() { return (unsigned)__builtin_amdgcn_s_getreg((3 << 11) | 20) & 0xFu; }
#define XB_SPIN(cond, bar) do { unsigned _sp = 0; while (cond) { __builtin_amdgcn_s_sleep(1); \
    if ((++_sp & 255u) == 0u) { if (xb_ld(&(bar)[XB_TMO])) break; if (_sp > XB_SPIN_CAP) { atomicAdd(&(bar)[XB_TMO], 1u); break; } } } } while (0)

struct XcdBarrier {
    unsigned* bar; unsigned x;
    volatile LAS unsigned* st;
};

__device__ __forceinline__ XcdBarrier xcd_barrier_post(unsigned* bar, volatile LAS unsigned* st) {
    XcdBarrier b; b.bar = bar; b.x = xb_xcc_id(); b.st = st;
    if (threadIdx.x == 0) (void)xb_add(&bar[XB_XCNT(b.x)], 1u);
    return b;
}
__device__ __forceinline__ void xcd_barrier_complete(unsigned* bar, unsigned x, unsigned& nloc, unsigned& nx) {
    const unsigned G = gridDim.x * gridDim.y * gridDim.z;
    unsigned sum, cnt, mine, sp = 0u;
    for (;;) {
        sum = 0u; cnt = 0u; mine = 0u;
#pragma unroll
        for (unsigned j = 0; j < 16; ++j) { const unsigned c = xb_ld(&bar[XB_XCNT(j)]); sum += c; cnt += (c > 0u) ? 1u : 0u; mine = (j == x) ? c : mine; }
        if (sum == G) break;
        __builtin_amdgcn_s_sleep(1);
        if ((++sp & 255u) == 0u) { if (xb_ld(&bar[XB_TMO])) break; if (sp > XB_SPIN_CAP) { atomicAdd(&bar[XB_TMO], 1u); break; } }
    }
    nloc = mine > 0u ? mine : 1u; nx = cnt > 0u ? cnt : 1u;
}

__device__ __forceinline__ void xcd_barrier(const XcdBarrier& b) {
    asm volatile("s_waitcnt vmcnt(0)" ::: "memory");
    __syncthreads();
    if (threadIdx.x == 0) {
        unsigned* bar = b.bar;
        __builtin_amdgcn_s_waitcnt(0);
        unsigned nloc = b.st[0], nx = b.st[1];
        if (nloc == 0u) { xcd_barrier_complete(bar, b.x, nloc, nx); b.st[0] = nloc; b.st[1] = nx; }
        const unsigned old = xb_add(&bar[XB_XSUB(b.x)], 1u);
        const unsigned gen = old / nloc;
        if (old + 1u == (gen + 1u) * nloc) {
            __builtin_amdgcn_fence(__ATOMIC_RELEASE, "agent");
            asm volatile("s_waitcnt vmcnt(0)" ::: "memory");
            const unsigned og = xb_add(&bar[XB_TOP], 1u);
            const unsigned tg = og / nx;
            if (og + 1u == (tg + 1u) * nx) xb_add(&bar[XB_TOPGEN], 1u);
            else XB_SPIN(xb_ld(&bar[XB_TOPGEN]) == tg, bar);
            __builtin_amdgcn_fence(__ATOMIC_ACQUIRE, "agent");
            xb_add(&bar[XB_XGEN(b.x)], 1u);
            asm volatile("s_waitcnt vmcnt(0)" ::: "memory");
        } else {
            XB_SPIN(xb_ld(&bar[XB_XGEN(b.x)]) == gen, bar);
            __builtin_amdgcn_fence(__ATOMIC_ACQUIRE, "agent");
            asm volatile("s_waitcnt vmcnt(0)" ::: "memory");
        }
    }
    __syncthreads();
}

constexpr int NWAVES = 8, NTHR = 512;
constexpr int D = 1024, NB = 8, SEQ = 8192, NMETA = 16;
constexpr int MX = NB * SEQ;
constexpr int META0 = MX;
constexpr int MV = MX + NMETA;
constexpr int TP = MX + 256;
constexpr int NT = TP / 256;
constexpr int XBCW = 1536, COLSW = 3328, DFF = 2816, NEXP = 8;
constexpr int IN0_SRC = 5904;
constexpr int IN0_N = 6144;
constexpr float ALPHA = 1.4142135623730951f;
constexpr float LN_EPS = 1e-5f;
constexpr int MOE_RMAX = 2 * MX + NEXP * 256;
constexpr int MOE_TMAX = MOE_RMAX / 256;
constexpr int MOE_CHUNK = 264;
constexpr int NCHUNK64 = MX / 64 + 1;

constexpr size_t MiB = 1u << 20;
constexpr size_t WS_CTL = 0, CTL_ZERO_BYTES = 1 * MiB;
constexpr size_t WS_H = 1 * MiB;
constexpr size_t WS_XBC = 130 * MiB;
constexpr size_t WS_COLS = 323 * MiB;
constexpr size_t WS_Y = 741 * MiB;
constexpr size_t WS_DT = 998 * MiB;
constexpr size_t WS_SM = 1003 * MiB;
constexpr size_t WS_WIN1T = WS_SM, WS_WOUT1T = WS_SM + 4 * MiB, WS_GXT = WS_SM + 6 * MiB, WS_GAT = WS_GXT + 256 * 1024;
constexpr size_t WS_WUPT = WS_SM + 6 * MiB + 512 * 1024, WS_AUPT = WS_WUPT + 128 * 1024, WS_GUPT = WS_AUPT + 128 * 1024;
constexpr size_t WS_TOPE = WS_SM + 7 * MiB, WS_TOPG = WS_TOPE + 256 * 1024, WS_SLOTP = WS_TOPG + 512 * 1024, WS_ROWTOK = WS_SLOTP + 512 * 1024;
constexpr size_t WS_TILEE = WS_SM + 9 * MiB;
constexpr size_t WS_CARP = WS_SM + 10 * MiB, WS_CARH = WS_SM + 15 * MiB;
constexpr size_t WS_END = 1024 * MiB;
static_assert(WS_CARH + (size_t)NCHUNK64 * 1024 * 4 <= WS_END, "ws map");
static_assert(WS_ROWTOK + (size_t)MOE_RMAX * 4 <= WS_TILEE, "ws map");
constexpr size_t WS_WEGU = WS_XBC, WS_WEDN = WS_XBC + 88 * MiB;
constexpr size_t WS_ACT0 = WS_COLS;
constexpr size_t WS_G1 = WS_Y, WS_XR = WS_Y + (size_t)TP * 2048;
constexpr size_t WS_LA = WS_COLS, WS_U = WS_XR;
static_assert(WS_LA + (size_t)TP * 4096 <= WS_COLS + 300 * MiB, "ws map");
constexpr size_t WS_XG = WS_COLS, WS_YSLOT = WS_Y;
constexpr size_t WS_H8 = WS_COLS + 300 * MiB;
constexpr size_t WS_H81 = WS_COLS;
constexpr size_t WS_H80 = WS_Y;
constexpr size_t WS_SROW = WS_CARP, WS_SSLOT = WS_CARP + 1 * MiB;
static_assert(WS_YSLOT + (size_t)MOE_RMAX * 2048 <= WS_SM, "ws map");
constexpr size_t DO_Z = 0;
constexpr size_t DO_WINT = 129 * MiB, DO_WOUTT = 141 * MiB, DO_WGUT = 145 * MiB, DO_WDNT = 156 * MiB;
constexpr size_t DO_LIN = 162 * MiB;
constexpr size_t DO_WIN8 = 206 * MiB;
constexpr size_t DO_WGU8 = 200 * MiB;
constexpr size_t DO_SIDE = 214 * MiB;
constexpr size_t DO_DTX = 224 * MiB;
constexpr size_t DO_WDN8 = 241 * MiB;
constexpr size_t DO_WIN18 = 245 * MiB;
constexpr size_t WS_ACTM = WS_COLS + 130 * MiB;
static_assert(WS_ACTM + (size_t)MOE_CHUNK * 256 * DFF <= WS_Y, "ws map");
constexpr float ACT_CLIP = 8.0f;
constexpr float W_CLIP = 0.78f;
static_assert((size_t)MOE_CHUNK * 256 * DFF <= 256 * MiB && DO_WDNT + (size_t)D * DFF * 2 <= 256 * MiB, "d_out map");
constexpr int CW_BAR = 4096;
constexpr int CW_CNT = 16384;
constexpr int CW_CUR = 16384 + 64;
constexpr int CW_GRP = 16384 + 512;
constexpr int CW_EAMAX = 16384 + 128;

constexpr int RING_BYTES = 131072;
constexpr int LDSCTL_OFF = 146944, MISC_OFF = LDSCTL_OFF + 320;
constexpr int LDS_BYTES = 147456;

struct Args { const float* in[43]; float* out; unsigned char* ws; int ph_lo, ph_hi; };
struct Frame {
    const Args* A;
    LAS unsigned char* lds;
    volatile LAS unsigned* MISC;
    gu32* ctl;
    int tid, lane, wave, G;
    int wi, wn;
    unsigned char* ws; unsigned char* dout;
};
enum { I_X = 0, I_META, I_EV_W_IN, I_EV_CONV_W, I_EV_CONV_B, I_EV_DT_BIAS, I_EV_A_LOG, I_EV_D_SKIP, I_EV_SSM_NORM, I_EV_SHIFT_MU, I_EV_W0, I_EV_W_UP, I_EV_A0, I_EV_A_UP, I_EV_G_UP,
       I_EV_K_K, I_EV_K_A, I_EV_R_K, I_EV_LNX_G, I_EV_LNX_B, I_EV_W_OUT, I_EV_LN1_G, I_EV_LN1_B, I_EV_FFN_GU, I_EV_FFN_DN, I_EV_LN2_G, I_EV_LN2_B,
       I_OD_W_IN, I_OD_CONV_W, I_OD_CONV_B, I_OD_GX_W, I_OD_GX_B, I_OD_GA_W, I_OD_GA_B, I_OD_LAMBDA, I_OD_W_OUT, I_OD_LN1_G, I_OD_LN1_B, I_OD_ROUTER, I_OD_EXP_GU, I_OD_EXP_DN, I_OD_LN2_G, I_OD_LN2_B, N_IN };
static_assert(N_IN == 43, "inputs");

#define Q8_MAGIC 12582912.0f
__device__ __forceinline__ unsigned pack4_lowbytes(float f0, float f1, float f2, float f3) {
    const unsigned t1 = __builtin_amdgcn_perm(__builtin_bit_cast(unsigned, f1), __builtin_bit_cast(unsigned, f0), 0x0c0c0400u), t2 = __builtin_amdgcn_perm(__builtin_bit_cast(unsigned, f3), __builtin_bit_cast(unsigned, f2), 0x0c0c0400u);
    return t1 | (t2 << 16);
}
__device__ __forceinline__ unsigned q8pack4c(float a, float b, float c, float d, float inv) {
    return pack4_lowbytes(__builtin_amdgcn_fmed3f(a * inv, -127.f, 127.f) + Q8_MAGIC, __builtin_amdgcn_fmed3f(b * inv, -127.f, 127.f) + Q8_MAGIC, __builtin_amdgcn_fmed3f(c * inv, -127.f, 127.f) + Q8_MAGIC, __builtin_amdgcn_fmed3f(d * inv, -127.f, 127.f) + Q8_MAGIC);
}
__device__ __forceinline__ unsigned q8pack4(float a, float b, float c, float d, float inv) {
    return pack4_lowbytes(__builtin_fmaf(a, inv, Q8_MAGIC), __builtin_fmaf(b, inv, Q8_MAGIC), __builtin_fmaf(c, inv, Q8_MAGIC), __builtin_fmaf(d, inv, Q8_MAGIC));
}
typedef float accT[2][2][4][2] __attribute__((unused));
struct EpiIn0 {
    static constexpr bool PERM = true, AFTER_DRAIN = false, PREFETCH = false;
    bf16* Z; bf16* XBC; bf16* COLS; float* DT;
    __device__ __forceinline__ void operator()(const f32x4 (&acc)[2][2][4][2], const pg8::Unit& u, int wr, int wc, int fr, int fq) const {
        const int row0 = u.pm * 256 + wr * 64 + fr;
        if (u.pn == 23) {
            if (wc == 0 && fq < 2) {
#pragma unroll
                for (int ai = 0; ai < 2; ++ai)
#pragma unroll
                    for (int m = 0; m < 4; ++m) { float* p = DT + (size_t)(row0 + ai * 128 + m * 16) * 16 + 8 * fq; *(f32x4*)p = acc[ai][0][m][0]; *(f32x4*)(p + 4) = acc[ai][0][m][1]; }
            }
            return;
        }
        bf16* base; int ldc, ct;
        if (u.pn < 4) { base = Z; ldc = 1024; ct = u.pn; } else if (u.pn < 10) { base = XBC; ldc = XBCW; ct = u.pn - 4; } else { base = COLS; ldc = COLSW; ct = u.pn - 10; }
        const int col0 = ct * 256 + wc * 32 + 8 * fq;
#pragma unroll
        for (int ai = 0; ai < 2; ++ai)
#pragma unroll
            for (int m = 0; m < 4; ++m) { bf16* rowp = base + (size_t)(row0 + ai * 128 + m * 16) * ldc + col0;
#pragma unroll
                for (int bj = 0; bj < 2; ++bj) { const f32x4 v0 = acc[ai][bj][m][0], v1 = acc[ai][bj][m][1];
                    v4u w; w.x = cvt_pk_bf16(v0[0], v0[1]); w.y = cvt_pk_bf16(v0[2], v0[3]); w.z = cvt_pk_bf16(v1[0], v1[1]); w.w = cvt_pk_bf16(v1[2], v1[3]);
                    *(v4u*)(rowp + bj * 128) = w; } }
    }
};
struct EpiIn0I8 {
    static constexpr bool PERM = true, AFTER_DRAIN = false, PREFETCH = true;
    bf16* Z; bf16* XBC; bf16* COLS; float* DT; const float* srow; const unsigned* wamax; float sc[2][4];
    __device__ __forceinline__ void prefetch(const pg8::Unit& u, int wr, int wc, int fr, int fq) { const int row0 = u.pm * 256 + wr * 64 + fr; const float sw = __builtin_bit_cast(float, wamax[0]) * (1.0f / 127.0f);
#pragma unroll
        for (int ai = 0; ai < 2; ++ai)
#pragma unroll
            for (int m = 0; m < 4; ++m) sc[ai][m] = srow[row0 + ai * 128 + m * 16] * sw; }
    __device__ __forceinline__ void operator()(const pg8::i32x4 (&acc)[2][2][4][2], const pg8::Unit& u, int wr, int wc, int fr, int fq) const {
        const int row0 = u.pm * 256 + wr * 64 + fr;
        if (u.pn == 23) {
            if (wc == 0 && fq < 2) {
#pragma unroll
                for (int ai = 0; ai < 2; ++ai)
#pragma unroll
                    for (int m = 0; m < 4; ++m) { const int r = row0 + ai * 128 + m * 16; const float s = sc[ai][m]; float* p = DT + (size_t)r * 16 + 8 * fq; const pg8::i32x4 a0 = acc[ai][0][m][0], a1 = acc[ai][0][m][1];
                        *(f32x4*)p = (f32x4){(float)a0[0] * s, (float)a0[1] * s, (float)a0[2] * s, (float)a0[3] * s}; *(f32x4*)(p + 4) = (f32x4){(float)a1[0] * s, (float)a1[1] * s, (float)a1[2] * s, (float)a1[3] * s}; }
            }
            return;
        }
        bf16* base; int ldc, ct;
        if (u.pn < 4) { base = Z; ldc = 1024; ct = u.pn; } else if (u.pn < 10) { base = XBC; ldc = XBCW; ct = u.pn - 4; } else { base = COLS; ldc = COLSW; ct = u.pn - 10; }
        const int col0 = ct * 256 + wc * 32 + 8 * fq;
#pragma unroll
        for (int ai = 0; ai < 2; ++ai)
#pragma unroll
            for (int m = 0; m < 4; ++m) { const int r = row0 + ai * 128 + m * 16; const float s = sc[ai][m]; bf16* rowp = base + (size_t)r * ldc + col0;
#pragma unroll
                for (int bj = 0; bj < 2; ++bj) { const pg8::i32x4 v0 = acc[ai][bj][m][0], v1 = acc[ai][bj][m][1];
                    v4u w; w.x = cvt_pk_bf16((float)v0[0] * s, (float)v0[1] * s); w.y = cvt_pk_bf16((float)v0[2] * s, (float)v0[3] * s); w.z = cvt_pk_bf16((float)v1[0] * s, (float)v1[1] * s); w.w = cvt_pk_bf16((float)v1[2] * s, (float)v1[3] * s);
                    *(v4u*)(rowp + bj * 128) = w; } }
    }
};
struct EpiResid {
    static constexpr bool PERM = true, AFTER_DRAIN = false, PREFETCH = false;
    const bf16* Hres; bf16* S;
    __device__ __forceinline__ void operator()(const f32x4 (&acc)[2][2][4][2], const pg8::Unit& u, int wr, int wc, int fr, int fq) const {
        const int row0 = u.pm * 256 + wr * 64 + fr, col0 = u.pn * 256 + wc * 32 + 8 * fq;
v4u h[2][4][2];
#pragma unroll
        for (int ai = 0; ai < 2; ++ai)
#pragma unroll
            for (int m = 0; m < 4; ++m)
#pragma unroll
                for (int bj = 0; bj < 2; ++bj) h[ai][m][bj] = *(const v4u*)(Hres + (size_t)(row0 + ai * 128 + m * 16) * 1024 + col0 + bj * 128);
#pragma unroll
        for (int ai = 0; ai < 2; ++ai)
#pragma unroll
            for (int m = 0; m < 4; ++m) { const size_t off = (size_t)(row0 + ai * 128 + m * 16) * 1024 + col0;
#pragma unroll
                for (int bj = 0; bj < 2; ++bj) { const v4u hh = h[ai][m][bj]; const f32x4 v0 = acc[ai][bj][m][0], v1 = acc[ai][bj][m][1];
                    v4u w; w.x = cvt_pk_bf16(ALPHA * bflo(hh.x) + v0[0], ALPHA * bfhi(hh.x) + v0[1]); w.y = cvt_pk_bf16(ALPHA * bflo(hh.y) + v0[2], ALPHA * bfhi(hh.y) + v0[3]);
                    w.z = cvt_pk_bf16(ALPHA * bflo(hh.z) + v1[0], ALPHA * bfhi(hh.z) + v1[1]); w.w = cvt_pk_bf16(ALPHA * bflo(hh.w) + v1[2], ALPHA * bfhi(hh.w) + v1[3]);
                    *(v4u*)(S + off + bj * 128) = w; } }
    }
};
struct EpiSwiglu {
    static constexpr bool PERM = true, AFTER_DRAIN = false, PREFETCH = false;
    bf16* ACT; int row_sub;
    __device__ __forceinline__ void operator()(const f32x4 (&acc)[2][2][4][2], const pg8::Unit& u, int wr, int wc, int fr, int fq) const {
        const int row0 = u.pm * 256 + wr * 64 + fr - row_sub, col0 = u.pn * 128 + wc * 32 + 8 * fq;
#pragma unroll
        for (int ai = 0; ai < 2; ++ai)
#pragma unroll
            for (int m = 0; m < 4; ++m) { bf16* p = ACT + (size_t)(row0 + ai * 128 + m * 16) * DFF + col0;
                const f32x4 g0 = acc[ai][0][m][0], g1 = acc[ai][0][m][1], u0 = acc[ai][1][m][0], u1 = acc[ai][1][m][1];
                v4u w; w.x = cvt_pk_bf16(siluf_(g0[0]) * u0[0], siluf_(g0[1]) * u0[1]); w.y = cvt_pk_bf16(siluf_(g0[2]) * u0[2], siluf_(g0[3]) * u0[3]);
                w.z = cvt_pk_bf16(siluf_(g1[0]) * u1[0], siluf_(g1[1]) * u1[1]); w.w = cvt_pk_bf16(siluf_(g1[2]) * u1[2], siluf_(g1[3]) * u1[3]);
                *(v4u*)p = w; }
    }
};
template <bool OUT_I8> struct EpiSwigluI8 {
    static constexpr bool PERM = true, AFTER_DRAIN = false, PREFETCH = true;
    void* ACT; int row_sub; const float* sslot; const int* tile_e; const unsigned* eamax; float sc[2][4];
    __device__ __forceinline__ void prefetch(const pg8::Unit& u, int wr, int wc, int fr, int fq) { const int rowg = u.pm * 256 + wr * 64 + fr; const float sw = __builtin_bit_cast(float, eamax[tile_e ? u.pe : 0]) * (1.0f / 127.0f);
#pragma unroll
        for (int ai = 0; ai < 2; ++ai)
#pragma unroll
            for (int m = 0; m < 4; ++m) sc[ai][m] = sslot[rowg + ai * 128 + m * 16] * sw; }
    __device__ __forceinline__ void operator()(const pg8::i32x4 (&acc)[2][2][4][2], const pg8::Unit& u, int wr, int wc, int fr, int fq) const {
        const int rowg = u.pm * 256 + wr * 64 + fr, row0 = rowg - row_sub, col0 = u.pn * 128 + wc * 32 + 8 * fq;
#pragma unroll
        for (int ai = 0; ai < 2; ++ai)
#pragma unroll
            for (int m = 0; m < 4; ++m) { const float s = sc[ai][m];
                const pg8::i32x4 g0 = acc[ai][0][m][0], g1 = acc[ai][0][m][1], u0 = acc[ai][1][m][0], u1 = acc[ai][1][m][1]; float v[8];
                if (OUT_I8) {
                    const float k1 = -s * 1.4426950408889634f, k2 = s * s * (127.0f / ACT_CLIP);
#pragma unroll
                    for (int j = 0; j < 4; ++j) { const float ga = (float)g0[j], ua = (float)u0[j], gb = (float)g1[j], ub = (float)u1[j];
                        const float ra = fast_rcp(1.0f + __builtin_amdgcn_exp2f(ga * k1)) * k2, rb = fast_rcp(1.0f + __builtin_amdgcn_exp2f(gb * k1)) * k2;
                        v[j] = __builtin_amdgcn_fmed3f((ga * ua) * ra, -127.f, 127.f) + Q8_MAGIC; v[4 + j] = __builtin_amdgcn_fmed3f((gb * ub) * rb, -127.f, 127.f) + Q8_MAGIC; }
                    v2u w; w.x = pack4_lowbytes(v[0], v[1], v[2], v[3]); w.y = pack4_lowbytes(v[4], v[5], v[6], v[7]);
                    *(v2u*)((unsigned char*)ACT + (size_t)(row0 + ai * 128 + m * 16) * DFF + col0) = w; }
                else {
#pragma unroll
                    for (int j = 0; j < 4; ++j) { v[j] = siluf_((float)g0[j] * s) * ((float)u0[j] * s); v[4 + j] = siluf_((float)g1[j] * s) * ((float)u1[j] * s); }
                    v4u w; w.x = cvt_pk_bf16(v[0], v[1]); w.y = cvt_pk_bf16(v[2], v[3]); w.z = cvt_pk_bf16(v[4], v[5]); w.w = cvt_pk_bf16(v[6], v[7]);
                    *(v4u*)((bf16*)ACT + (size_t)(row0 + ai * 128 + m * 16) * DFF + col0) = w; } }
    }
};
struct EpiPlainI8 {
    static constexpr bool PERM = true, AFTER_DRAIN = false, PREFETCH = true;
    bf16* O; const int* tile_e; const unsigned* eamax; float s;
    __device__ __forceinline__ void prefetch(const pg8::Unit& u, int, int, int, int) { s = __builtin_bit_cast(float, eamax[u.pe]) * (1.0f / 127.0f) * (ACT_CLIP / 127.0f); }
    __device__ __forceinline__ void operator()(const pg8::i32x4 (&acc)[2][2][4][2], const pg8::Unit& u, int wr, int wc, int fr, int fq) const {
        const int row0 = u.pm * 256 + wr * 64 + fr, col0 = u.pn * 256 + wc * 32 + 8 * fq;
#pragma unroll
        for (int ai = 0; ai < 2; ++ai)
#pragma unroll
            for (int m = 0; m < 4; ++m) { bf16* rowp = O + (size_t)(row0 + ai * 128 + m * 16) * 1024 + col0;
#pragma unroll
                for (int bj = 0; bj < 2; ++bj) { const pg8::i32x4 v0 = acc[ai][bj][m][0], v1 = acc[ai][bj][m][1];
                    v4u w; w.x = cvt_pk_bf16((float)v0[0] * s, (float)v0[1] * s); w.y = cvt_pk_bf16((float)v0[2] * s, (float)v0[3] * s); w.z = cvt_pk_bf16((float)v1[0] * s, (float)v1[1] * s); w.w = cvt_pk_bf16((float)v1[2] * s, (float)v1[3] * s);
                    *(v4u*)(rowp + bj * 128) = w; } }
    }
};
struct EpiResidI8 {
    static constexpr bool PERM = true, AFTER_DRAIN = false, PREFETCH = true;
    const bf16* Hres; bf16* S; const unsigned* eamax; float s;
    __device__ __forceinline__ void prefetch(const pg8::Unit&, int, int, int, int) { s = __builtin_bit_cast(float, eamax[0]) * (1.0f / 127.0f) * (ACT_CLIP / 127.0f); }
    __device__ __forceinline__ void operator()(const pg8::i32x4 (&acc)[2][2][4][2], const pg8::Unit& u, int wr, int wc, int fr, int fq) const {
        const int row0 = u.pm * 256 + wr * 64 + fr, col0 = u.pn * 256 + wc * 32 + 8 * fq;
v4u h[2][4][2];
#pragma unroll
        for (int ai = 0; ai < 2; ++ai)
#pragma unroll
            for (int m = 0; m < 4; ++m)
#pragma unroll
                for (int bj = 0; bj < 2; ++bj) h[ai][m][bj] = *(const v4u*)(Hres + (size_t)(row0 + ai * 128 + m * 16) * 1024 + col0 + bj * 128);
#pragma unroll
        for (int ai = 0; ai < 2; ++ai)
#pragma unroll
            for (int m = 0; m < 4; ++m) { const size_t off = (size_t)(row0 + ai * 128 + m * 16) * 1024 + col0;
#pragma unroll
                for (int bj = 0; bj < 2; ++bj) { const v4u hh = h[ai][m][bj]; const pg8::i32x4 v0 = acc[ai][bj][m][0], v1 = acc[ai][bj][m][1];
                    v4u w; w.x = cvt_pk_bf16(ALPHA * bflo(hh.x) + (float)v0[0] * s, ALPHA * bfhi(hh.x) + (float)v0[1] * s); w.y = cvt_pk_bf16(ALPHA * bflo(hh.y) + (float)v0[2] * s, ALPHA * bfhi(hh.y) + (float)v0[3] * s);
                    w.z = cvt_pk_bf16(ALPHA * bflo(hh.z) + (float)v1[0] * s, ALPHA * bfhi(hh.z) + (float)v1[1] * s); w.w = cvt_pk_bf16(ALPHA * bflo(hh.w) + (float)v1[2] * s, ALPHA * bfhi(hh.w) + (float)v1[3] * s);
                    *(v4u*)(S + off + bj * 128) = w; } }
    }
};
__device__ __forceinline__ float gelu_tanh(float x) { const float y = 1.5957691216057308f * (x + 0.044715f * x * x * x); return x * sigmoidf_(y); }
struct EpiIn1 {
    static constexpr bool PERM = true, AFTER_DRAIN = false, PREFETCH = false;
    bf16* G1; bf16* XR;
    __device__ __forceinline__ void operator()(const f32x4 (&acc)[2][2][4][2], const pg8::Unit& u, int wr, int wc, int fr, int fq) const {
        const int row0 = u.pm * 256 + wr * 64 + fr, col0 = (u.pn & 3) * 256 + wc * 32 + 8 * fq; const bool gate = u.pn < 4; bf16* base = gate ? G1 : XR;
#pragma unroll
        for (int ai = 0; ai < 2; ++ai)
#pragma unroll
            for (int m = 0; m < 4; ++m) { bf16* rowp = base + (size_t)(row0 + ai * 128 + m * 16) * 1024 + col0;
#pragma unroll
                for (int bj = 0; bj < 2; ++bj) { f32x4 v0 = acc[ai][bj][m][0], v1 = acc[ai][bj][m][1];
                    if (gate) {
#pragma unroll
                        for (int j = 0; j < 4; ++j) { v0[j] = gelu_tanh(v0[j]); v1[j] = gelu_tanh(v1[j]); } }
                    v4u w; w.x = cvt_pk_bf16(v0[0], v0[1]); w.y = cvt_pk_bf16(v0[2], v0[3]); w.z = cvt_pk_bf16(v1[0], v1[1]); w.w = cvt_pk_bf16(v1[2], v1[3]);
                    *(v4u*)(rowp + bj * 128) = w; } }
    }
};
struct EpiIn1I8 {
    static constexpr bool PERM = true, AFTER_DRAIN = false, PREFETCH = true;
    bf16* G1; bf16* XR; const float* srow; const unsigned* eamax; float sc[2][4];
    __device__ __forceinline__ void prefetch(const pg8::Unit& u, int wr, int, int fr, int) { const int rowg = u.pm * 256 + wr * 64 + fr; const float sw = __builtin_bit_cast(float, eamax[0]) * (1.0f / 127.0f);
#pragma unroll
        for (int ai = 0; ai < 2; ++ai)
#pragma unroll
            for (int m = 0; m < 4; ++m) sc[ai][m] = srow[rowg + ai * 128 + m * 16] * sw; }
    __device__ __forceinline__ void operator()(const pg8::i32x4 (&acc)[2][2][4][2], const pg8::Unit& u, int wr, int wc, int fr, int fq) const {
        const int row0 = u.pm * 256 + wr * 64 + fr, col0 = (u.pn & 3) * 256 + wc * 32 + 8 * fq; const bool gate = u.pn < 4; bf16* base = gate ? G1 : XR;
#pragma unroll
        for (int ai = 0; ai < 2; ++ai)
#pragma unroll
            for (int m = 0; m < 4; ++m) { bf16* rowp = base + (size_t)(row0 + ai * 128 + m * 16) * 1024 + col0; const float s = sc[ai][m];
#pragma unroll
                for (int bj = 0; bj < 2; ++bj) { const pg8::i32x4 i0 = acc[ai][bj][m][0], i1 = acc[ai][bj][m][1]; f32x4 v0, v1;
#pragma unroll
                    for (int j = 0; j < 4; ++j) { v0[j] = (float)i0[j] * s; v1[j] = (float)i1[j] * s; }
                    if (gate) {
#pragma unroll
                        for (int j = 0; j < 4; ++j) { v0[j] = gelu_tanh(v0[j]); v1[j] = gelu_tanh(v1[j]); } }
                    v4u w; w.x = cvt_pk_bf16(v0[0], v0[1]); w.y = cvt_pk_bf16(v0[2], v0[3]); w.z = cvt_pk_bf16(v1[0], v1[1]); w.w = cvt_pk_bf16(v1[2], v1[3]);
                    *(v4u*)(rowp + bj * 128) = w; } }
    }
};
struct EpiPlain {
    static constexpr bool PERM = true, AFTER_DRAIN = false, PREFETCH = false;
    bf16* O;
    __device__ __forceinline__ void operator()(const f32x4 (&acc)[2][2][4][2], const pg8::Unit& u, int wr, int wc, int fr, int fq) const {
        const int row0 = u.pm * 256 + wr * 64 + fr, col0 = u.pn * 256 + wc * 32 + 8 * fq;
#pragma unroll
        for (int ai = 0; ai < 2; ++ai)
#pragma unroll
            for (int m = 0; m < 4; ++m) { bf16* rowp = O + (size_t)(row0 + ai * 128 + m * 16) * 1024 + col0;
#pragma unroll
                for (int bj = 0; bj < 2; ++bj) { const f32x4 v0 = acc[ai][bj][m][0], v1 = acc[ai][bj][m][1];
                    v4u w; w.x = cvt_pk_bf16(v0[0], v0[1]); w.y = cvt_pk_bf16(v0[2], v0[3]); w.z = cvt_pk_bf16(v1[0], v1[1]); w.w = cvt_pk_bf16(v1[2], v1[3]);
                    *(v4u*)(rowp + bj * 128) = w; } }
    }
};
struct MoeOrder {
    int toff[7]; int t0, nbt; pg8::StaticOrder so;
    __device__ __forceinline__ bool next(int i, pg8::Unit& u) const {
        const int L = i * so.G + so.c; if (L >= so.nwg) return false;
        const int nN = so.nN, nig = 8 * nN, nM1 = so.nM & ~63, nwg1 = nM1 * nN;
        if (L < nwg1) {
            const int xcd = L & 7, off = L >> 3, k = off / nig, w = off - k * nig;
            u.pm = (k * 8 + xcd) * 8 + (w & 7); u.pn = w >> 3;
        } else {
            const int nM2 = so.nM - nM1, nwg2 = nM2 * nN; int wgid = L - nwg1;
            { const int q = nwg2 / 8, r = nwg2 % 8, xcd = wgid % 8, off = wgid / 8; wgid = (xcd < r ? xcd * (q + 1) : r * (q + 1) + (xcd - r) * q) + off; }
            const int gid = wgid / nig, fm = gid * 8, gsz = (nM2 - fm) < 8 ? (nM2 - fm) : 8;
            u.pm = nM1 + fm + ((wgid % nig) % gsz); u.pn = (wgid % nig) / gsz;
        }
        u.pm += t0; int e = 0;
#pragma unroll
        for (int k = 0; k < 7; ++k) e += (u.pm >= toff[k]) ? 1 : 0;
        u.pe = e; u.pb = e * nbt + u.pn; return true;
    }
    __device__ __forceinline__ void a_ready(const pg8::Unit&) const {}
    __device__ __forceinline__ void done(const pg8::Unit&) const {}
};

__device__ __forceinline__ void tr_load(float (&tv)[32], const float* W, int ldw, int k0, int c0, int lane) {
#pragma unroll
    for (int i = 0; i < 32; ++i) tv[i] = W[(size_t)(k0 + 2 * i + (lane >> 5)) * ldw + c0 + (lane & 31)];
}
__device__ __forceinline__ void tr_store(const float (&tv)[32], int K, int k0, bf16* WT, int n0, int nvalid, LAS float* scr, int lane) {
#pragma unroll
    for (int i = 0; i < 32; ++i) scr[(2 * i + (lane >> 5)) * 33 + (lane & 31)] = tv[i];
    LDS_WAIT(); asm volatile("" ::: "memory");
    const int c = lane & 7;
#pragma unroll
    for (int j = 0; j < 4; ++j) { const int n = (lane >> 3) + 8 * j; const LAS float* s = scr + (8 * c) * 33 + n;
        v4u o; o.x = cvt_pk_bf16(s[0 * 33], s[1 * 33]); o.y = cvt_pk_bf16(s[2 * 33], s[3 * 33]); o.z = cvt_pk_bf16(s[4 * 33], s[5 * 33]); o.w = cvt_pk_bf16(s[6 * 33], s[7 * 33]);
        if (n >= nvalid) o = (v4u){0u, 0u, 0u, 0u};
        *(GAS v4u*)(WT + (size_t)(n0 + n) * K + k0 + 8 * c) = o; }
    LDS_WAIT(); asm volatile("" ::: "memory");
}
__device__ __forceinline__ void tr_store_i8(const float (&tv)[32], int K, int k0, unsigned char* WT, int n0, float inv, LAS float* scr, int lane) {
#pragma unroll
    for (int i = 0; i < 32; ++i) scr[(2 * i + (lane >> 5)) * 33 + (lane & 31)] = tv[i];
    LDS_WAIT(); asm volatile("" ::: "memory");
    const int c = lane & 7;
#pragma unroll
    for (int j = 0; j < 4; ++j) { const int n = (lane >> 3) + 8 * j; const LAS float* s = scr + (8 * c) * 33 + n;
        v2u o; o.x = q8pack4c(s[0 * 33], s[1 * 33], s[2 * 33], s[3 * 33], inv); o.y = q8pack4c(s[4 * 33], s[5 * 33], s[6 * 33], s[7 * 33], inv);
        *(GAS v2u*)(WT + (size_t)(n0 + n) * K + k0 + 8 * c) = o; }
    LDS_WAIT(); asm volatile("" ::: "memory");
}
template <int KIND, bool I8> __device__ __forceinline__ void tr_matrix_x(Frame& F, const float* W, int ldw, int K, int N, void* WT, float inv, int& rot) {
    LAS float* scr = (LAS float*)(F.lds + F.wave * 16384);
    const int gw = F.wi * NWAVES + F.wave, NGW = F.wn * NWAVES, lane = F.lane;
    const int nblk = N / 32, nitems = (K / 64) * nblk;
    int start = gw - (rot % NGW); if (start < 0) start += NGW;
    rot += nitems;
    auto item = [&](int it, int& k0, int& c0, int& n0, int& nvalid, float& sc) { const int kb = it / nblk, nb = it % nblk; n0 = nb * 32; k0 = kb * 64; c0 = n0; nvalid = 32; sc = inv;
        if (KIND == 1) { if (n0 >= 5888) { c0 = 2560 + (n0 - 5888); nvalid = 5904 - n0; if (nvalid < 0) nvalid = 0; if (nvalid > 32) nvalid = 32; if (n0 >= 5904) sc = 0.f; if (c0 + 32 > IN0_SRC) c0 = 0; } else if (n0 >= 2560) c0 = n0 + 16; }
        if (KIND == 2) { const int pn = n0 >> 8, q = n0 & 255; c0 = q < 128 ? 128 * pn + q : DFF + 128 * pn + (q - 128); } };
    auto put = [&](const float (&tv)[32], int k0, int n0, int nvalid, float sc) { if (I8) tr_store_i8(tv, K, k0, (unsigned char*)WT, n0, sc, scr, lane); else tr_store(tv, K, k0, (bf16*)WT, n0, nvalid, scr, lane); };
    float ta[32], tb[32]; int ka = 0, ca = 0, na = 0, va = 0, kb_ = 0, cb = 0, nb_ = 0, vb = 0; float sa = 0.f, sb = 0.f;
    int it = start;
    if (it < nitems) { item(it, ka, ca, na, va, sa); tr_load(ta, W, ldw, ka, ca, lane); }
    while (it < nitems) {
        const int it2 = it + NGW;
        if (it2 < nitems) { item(it2, kb_, cb, nb_, vb, sb); tr_load(tb, W, ldw, kb_, cb, lane); }
        put(ta, ka, na, va, sa);
        if (it2 >= nitems) break;
        const int it3 = it2 + NGW;
        if (it3 < nitems) { item(it3, ka, ca, na, va, sa); tr_load(ta, W, ldw, ka, ca, lane); }
        put(tb, kb_, nb_, vb, sb);
        it = it3;
    }
}
template <int KIND> __device__ __forceinline__ void tr_matrix(Frame& F, const float* W, int ldw, int K, int N, bf16* WT, int& rot) { tr_matrix_x<KIND, false>(F, W, ldw, K, N, (void*)WT, 0.f, rot); }
template <int KIND> __device__ __forceinline__ void tr_matrix_i8(Frame& F, const float* W, int ldw, int K, int N, unsigned char* WT, float inv, int& rot) { tr_matrix_x<KIND, true>(F, W, ldw, K, N, (void*)WT, inv, rot); }
struct LnAffine { f32x4 g0, g1, g2, g3, b0, b1, b2, b3; };
__device__ __forceinline__ LnAffine ln_affine(const float* g, const float* b, int lane) { LnAffine A;
    A.g0 = *(const f32x4*)(g + 8 * lane); A.g1 = *(const f32x4*)(g + 8 * lane + 4); A.g2 = *(const f32x4*)(g + 512 + 8 * lane); A.g3 = *(const f32x4*)(g + 512 + 8 * lane + 4);
    A.b0 = *(const f32x4*)(b + 8 * lane); A.b1 = *(const f32x4*)(b + 8 * lane + 4); A.b2 = *(const f32x4*)(b + 512 + 8 * lane); A.b3 = *(const f32x4*)(b + 512 + 8 * lane + 4); return A; }
__device__ __forceinline__ void ln_row(const v4u a, const v4u c, bf16* orow, const LnAffine& A, int lane, float (&y)[16]) {
    float v[16] = {bflo(a.x), bfhi(a.x), bflo(a.y), bfhi(a.y), bflo(a.z), bfhi(a.z), bflo(a.w), bfhi(a.w), bflo(c.x), bfhi(c.x), bflo(c.y), bfhi(c.y), bflo(c.z), bfhi(c.z), bflo(c.w), bfhi(c.w)};
    float s = 0.f;
#pragma unroll
    for (int j = 0; j < 16; ++j) s += v[j];
    const float mean = wave_sum(s) * (1.f / D); float s2 = 0.f;
#pragma unroll
    for (int j = 0; j < 16; ++j) { v[j] -= mean; s2 += v[j] * v[j]; }
    const float rstd = 1.f / sqrtf(wave_sum(s2) * (1.f / D) + LN_EPS);
#pragma unroll
    for (int j = 0; j < 4; ++j) { y[j] = v[j] * rstd * A.g0[j] + A.b0[j]; y[4 + j] = v[4 + j] * rstd * A.g1[j] + A.b1[j]; y[8 + j] = v[8 + j] * rstd * A.g2[j] + A.b2[j]; y[12 + j] = v[12 + j] * rstd * A.g3[j] + A.b3[j]; }
    v4u o0, o1; o0.x = cvt_pk_bf16(y[0], y[1]); o0.y = cvt_pk_bf16(y[2], y[3]); o0.z = cvt_pk_bf16(y[4], y[5]); o0.w = cvt_pk_bf16(y[6], y[7]);
    o1.x = cvt_pk_bf16(y[8], y[9]); o1.y = cvt_pk_bf16(y[10], y[11]); o1.z = cvt_pk_bf16(y[12], y[13]); o1.w = cvt_pk_bf16(y[14], y[15]);
    *(v4u*)(orow + 8 * lane) = o0; *(v4u*)(orow + 512 + 8 * lane) = o1;
}

__device__ __forceinline__ void p0_prologue(Frame& F) {
    int rot = 0;
    tr_matrix<1>(F, F.A->in[I_EV_W_IN], IN0_SRC, D, IN0_N, (bf16*)(F.dout + DO_WINT), rot);
    tr_matrix<0>(F, F.A->in[I_EV_W_UP], D, 64, D, (bf16*)(F.ws + WS_WUPT), rot);
    tr_matrix<0>(F, F.A->in[I_EV_A_UP], D, 64, D, (bf16*)(F.ws + WS_AUPT), rot);
    tr_matrix<0>(F, F.A->in[I_EV_G_UP], D, 128, D, (bf16*)(F.ws + WS_GUPT), rot);
    const int gw = blockIdx.x * NWAVES + F.wave, NGW = F.G * NWAVES;
    bf16* H = (bf16*)(F.ws + WS_H);
    const float* X = F.A->in[I_X];
    const int nxr = (MX - gw + NGW - 1) / NGW, lastk = nxr - 1;
    auto issue = [&](f32x4 (&r)[4], int k) __attribute__((always_inline)) { const GAS f32x4* xr = (const GAS f32x4*)(X + (size_t)(gw + k * NGW) * D) + F.lane;
#pragma unroll
        for (int j = 0; j < 4; ++j) r[j] = xr[64 * j]; };
    auto conv = [&](const f32x4 (&xv)[4], int m) __attribute__((always_inline)) {
        GAS unsigned long long* o8 = (GAS unsigned long long*)(H + (size_t)m * D) + F.lane; float am = 0.f;
#pragma unroll
        for (int j = 0; j < 4; ++j) { const f32x4 v = xv[j]; o8[64 * j] = (unsigned long long)cvt_pk_bf16(v.x, v.y) | ((unsigned long long)cvt_pk_bf16(v.z, v.w) << 32); am = fmaxf(am, fmaxf(fmaxf(fabsf(v.x), fabsf(v.y)), fmaxf(fabsf(v.z), fabsf(v.w)))); }
        am = wave_max(am);
        const float inv = 127.0f / fmaxf(am, 1e-30f); unsigned* h8 = (unsigned*)((unsigned char*)(F.ws + WS_H80) + (size_t)m * D) + F.lane;
#pragma unroll
        for (int j = 0; j < 4; ++j) h8[64 * j] = q8pack4(xv[j].x, xv[j].y, xv[j].z, xv[j].w, inv);
        if (F.lane == 0) ((float*)(F.ws + WS_SROW))[m] = am * (1.0f / 127.0f); };
    f32x4 ra[4], rb[4];
    issue(ra, 0); issue(rb, lastk < 1 ? lastk : 1);
    for (int k = 0; k < nxr; k += 2) {
        f32x4 ca[4], cb[4];
#pragma unroll
        for (int j = 0; j < 4; ++j) { ca[j] = ra[j]; cb[j] = rb[j]; }
        issue(ra, k + 2 < lastk ? k + 2 : lastk); issue(rb, k + 3 < lastk ? k + 3 : lastk);
        conv(ca, gw + k * NGW); conv(cb, gw + (k + 1 < lastk ? k + 1 : lastk) * NGW);
    }
    for (int m = gw + nxr * NGW; m < TP; m += NGW) {
        GAS unsigned long long* o8 = (GAS unsigned long long*)(H + (size_t)m * D) + F.lane;
        if (m < MV) { const GAS f32x4* xr = (const GAS f32x4*)(F.A->in[I_META] + (size_t)(m - MX) * D) + F.lane;
#pragma unroll
            for (int j = 0; j < 4; ++j) { const f32x4 v = xr[64 * j]; o8[64 * j] = (unsigned long long)cvt_pk_bf16(v.x, v.y) | ((unsigned long long)cvt_pk_bf16(v.z, v.w) << 32); } }
        else {
#pragma unroll
            for (int j = 0; j < 4; ++j) o8[64 * j] = 0ull; }
    }
}
__device__ __forceinline__ void late_weights(Frame& F) {
    int rot = 0;
    tr_matrix<0>(F, F.A->in[I_EV_W_OUT], D, 2048, D, (bf16*)(F.dout + DO_WOUTT), rot);
    tr_matrix<2>(F, F.A->in[I_EV_FFN_GU], 2 * DFF, D, 2 * DFF, (bf16*)(F.dout + DO_WGUT), rot);
    tr_matrix<0>(F, F.A->in[I_EV_FFN_DN], D, DFF, D, (bf16*)(F.dout + DO_WDNT), rot);
    tr_matrix<0>(F, F.A->in[I_OD_W_IN], 2048, D, 2048, (bf16*)(F.ws + WS_WIN1T), rot);
    tr_matrix<0>(F, F.A->in[I_OD_W_OUT], D, D, D, (bf16*)(F.ws + WS_WOUT1T), rot);
    for (int hb = 0; hb < 8; ++hb) {
        tr_matrix<0>(F, F.A->in[I_OD_GX_W] + hb * 128 * 128, 128, 128, 128, (bf16*)(F.ws + WS_GXT) + hb * 128 * 128, rot);
        tr_matrix<0>(F, F.A->in[I_OD_GA_W] + hb * 128 * 128, 128, 128, 128, (bf16*)(F.ws + WS_GAT) + hb * 128 * 128, rot);
    }
}
__device__ __forceinline__ float amax_stream(Frame& F, const f32x4* w, size_t n4) {
#define AM4(v) fmaxf(fmaxf(fabsf((v).x), fabsf((v).y)), fmaxf(fabsf((v).z), fabsf((v).w)))
    const size_t st = (size_t)F.wn * NTHR; size_t i = (size_t)F.wi * NTHR + F.tid; float m0 = 0.f, m1 = 0.f, m2 = 0.f, m3 = 0.f;
    for (; i + 3 * st < n4; i += 4 * st) { const f32x4 a = w[i], b = w[i + st], c = w[i + 2 * st], d = w[i + 3 * st]; m0 = fmaxf(m0, AM4(a)); m1 = fmaxf(m1, AM4(b)); m2 = fmaxf(m2, AM4(c)); m3 = fmaxf(m3, AM4(d)); }
    for (; i < n4; i += st) { const f32x4 a = w[i]; m0 = fmaxf(m0, AM4(a)); }
    return fmaxf(fmaxf(m0, m1), fmaxf(m2, m3));
#undef AM4
}
template <bool EARLY> __device__ __forceinline__ void expert_amax_phase(Frame& F) {
    const size_t n4 = (size_t)D * 2 * DFF / 4;
    if (!EARLY) for (int e = 0; e < NEXP; ++e) { const f32x4* w = (const f32x4*)(F.A->in[I_OD_EXP_GU] + (size_t)e * D * 2 * DFF); float m = W_CLIP * wave_max(amax_stream(F, w, n4));
        if (F.lane == 0) __hip_atomic_fetch_max((unsigned*)(F.ctl + CW_EAMAX + e), __builtin_bit_cast(unsigned, m), RLX_AGENT); }
    if (!EARLY) for (int e = 0; e < NEXP; ++e) { const size_t m4 = (size_t)D * DFF / 4; const f32x4* w = (const f32x4*)(F.A->in[I_OD_EXP_DN] + (size_t)e * DFF * D); float m = W_CLIP * wave_max(amax_stream(F, w, m4));
        if (F.lane == 0) __hip_atomic_fetch_max((unsigned*)(F.ctl + CW_EAMAX + 16 + e), __builtin_bit_cast(unsigned, m), RLX_AGENT); }
    if (EARLY) { const size_t m4 = (size_t)D * IN0_SRC / 4; const f32x4* w = (const f32x4*)F.A->in[I_EV_W_IN]; float m = W_CLIP * wave_max(amax_stream(F, w, m4));
        if (F.lane == 0) __hip_atomic_fetch_max((unsigned*)(F.ctl + CW_EAMAX + 9), __builtin_bit_cast(unsigned, m), RLX_AGENT); }
    if (!EARLY) { const size_t m4 = (size_t)D * 2048 / 4; const f32x4* w = (const f32x4*)F.A->in[I_OD_W_IN]; float m = W_CLIP * wave_max(amax_stream(F, w, m4));
        if (F.lane == 0) __hip_atomic_fetch_max((unsigned*)(F.ctl + CW_EAMAX + 11), __builtin_bit_cast(unsigned, m), RLX_AGENT); }
    if (!EARLY) { const size_t m4 = (size_t)D * DFF / 4; const f32x4* w = (const f32x4*)F.A->in[I_EV_FFN_DN]; float m = W_CLIP * wave_max(amax_stream(F, w, m4));
        if (F.lane == 0) __hip_atomic_fetch_max((unsigned*)(F.ctl + CW_EAMAX + 10), __builtin_bit_cast(unsigned, m), RLX_AGENT); }
    if (!EARLY) { const size_t m4 = (size_t)D * 2 * DFF / 4; const f32x4* w = (const f32x4*)F.A->in[I_EV_FFN_GU]; float m = W_CLIP * wave_max(amax_stream(F, w, m4));
        if (F.lane == 0) __hip_atomic_fetch_max((unsigned*)(F.ctl + CW_EAMAX + 8), __builtin_bit_cast(unsigned, m), RLX_AGENT); }
}
__device__ __forceinline__ void convert_win8(Frame& F) {
    int rot = 0; const float amax = __builtin_bit_cast(float, __hip_atomic_load((unsigned*)(F.ctl + CW_EAMAX + 9), RLX_AGENT));
    tr_matrix_i8<1>(F, F.A->in[I_EV_W_IN], IN0_SRC, D, IN0_N, (unsigned char*)(F.dout + DO_WIN8), 127.0f / fmaxf(amax, 1e-30f), rot);
}
__device__ __forceinline__ void convert_wgu8(Frame& F) {
    int rot = 0; const float amax = __builtin_bit_cast(float, __hip_atomic_load((unsigned*)(F.ctl + CW_EAMAX + 8), RLX_AGENT));
    tr_matrix_i8<2>(F, F.A->in[I_EV_FFN_GU], 2 * DFF, D, 2 * DFF, (unsigned char*)(F.dout + DO_WGU8), 127.0f / fmaxf(amax, 1e-30f), rot);
    const float amaxd = __builtin_bit_cast(float, __hip_atomic_load((unsigned*)(F.ctl + CW_EAMAX + 10), RLX_AGENT));
    tr_matrix_i8<0>(F, F.A->in[I_EV_FFN_DN], D, DFF, D, (unsigned char*)(F.dout + DO_WDN8), 127.0f / fmaxf(amaxd, 1e-30f), rot);
    const float amaxi = __builtin_bit_cast(float, __hip_atomic_load((unsigned*)(F.ctl + CW_EAMAX + 11), RLX_AGENT));
    tr_matrix_i8<0>(F, F.A->in[I_OD_W_IN], 2048, D, 2048, (unsigned char*)(F.dout + DO_WIN18), 127.0f / fmaxf(amaxi, 1e-30f), rot);
}
__device__ __forceinline__ void convert_experts(Frame& F) {
    int rot = 0;
    for (int e = 0; e < NEXP; ++e) {
        const float amax = __builtin_bit_cast(float, __hip_atomic_load((unsigned*)(F.ctl + CW_EAMAX + e), RLX_AGENT));
        tr_matrix_i8<2>(F, F.A->in[I_OD_EXP_GU] + (size_t)e * D * 2 * DFF, 2 * DFF, D, 2 * DFF, (unsigned char*)(F.ws + WS_WEGU) + (size_t)e * 2 * DFF * D, 127.0f / fmaxf(amax, 1e-30f), rot);
        const float amaxd = __builtin_bit_cast(float, __hip_atomic_load((unsigned*)(F.ctl + CW_EAMAX + 16 + e), RLX_AGENT));
        tr_matrix_i8<0>(F, F.A->in[I_OD_EXP_DN] + (size_t)e * DFF * D, D, DFF, D, (unsigned char*)(F.ws + WS_WEDN) + (size_t)e * D * DFF, 127.0f / fmaxf(amaxd, 1e-30f), rot);
    }
}
__device__ __forceinline__ void row_to_i8(const float (&y)[16], unsigned char* h8row, float* srow, int lane) {
    float am = 0.f;
#pragma unroll
    for (int j = 0; j < 16; ++j) am = fmaxf(am, fabsf(y[j]));
    am = wave_max(am);
    const float inv = 127.0f / fmaxf(am, 1e-30f);
    v2u q0, q1; q0.x = q8pack4(y[0], y[1], y[2], y[3], inv); q0.y = q8pack4(y[4], y[5], y[6], y[7], inv); q1.x = q8pack4(y[8], y[9], y[10], y[11], inv); q1.y = q8pack4(y[12], y[13], y[14], y[15], inv);
    *(v2u*)(h8row + 8 * lane) = q0; *(v2u*)(h8row + 512 + 8 * lane) = q1; if (lane == 0) *srow = am * (1.0f / 127.0f);
}
template <bool WITH_I8> __device__ __forceinline__ void ln_phase(Frame& F, const bf16* S, bf16* H, const float* g, const float* b, size_t h8_off = WS_H80) {
    const int gw = blockIdx.x * NWAVES + F.wave, NGW = F.G * NWAVES;
    const LnAffine A = ln_affine(g, b, F.lane); v4u na = (v4u){0u, 0u, 0u, 0u}, nc = na;
    if (gw < MV) { na = *(const v4u*)(S + (size_t)gw * D + 8 * F.lane); nc = *(const v4u*)(S + (size_t)gw * D + 512 + 8 * F.lane); }
    for (int m = gw; m < MV; m += NGW) { const v4u a = na, c = nc; const int mn = m + NGW;
        if (mn < MV) { na = *(const v4u*)(S + (size_t)mn * D + 8 * F.lane); nc = *(const v4u*)(S + (size_t)mn * D + 512 + 8 * F.lane); }
        float y[16]; ln_row(a, c, H + (size_t)m * D, A, F.lane, y);
        if (WITH_I8 && m < MX) row_to_i8(y, (unsigned char*)(F.ws + h8_off) + (size_t)m * D, (float*)(F.ws + WS_SROW) + m, F.lane); }
}
__device__ __forceinline__ void zero_fill(Frame& F, void* p, size_t bytes) {
    GAS v4u* q = (GAS v4u*)p; const size_t n = bytes / 16;
    for (size_t i = (size_t)blockIdx.x * NTHR + F.tid; i < n; i += (size_t)F.G * NTHR) q[i] = (v4u){0u, 0u, 0u, 0u};
}

__device__ __forceinline__ int chunk_row(int ck, int t) {
    if (ck == MX / 64) return (t >= 0 && t < NMETA) ? META0 + t : -1;
    if (t >= 0) return ck * 64 + t;
    return (ck & 127) == 0 ? META0 + NMETA + t : ck * 64 + t;
}
constexpr int LRU_XC = 0, LRU_XF = 17408, LRU_RAW = 51200, LRU_LAU = 51200;
static_assert(LRU_LAU + 64 * 128 * 8 <= RING_BYTES, "lds");
__device__ __forceinline__ void lru_gates_phase(Frame& F) {
    const int tid = F.tid, lane = F.lane, wv = F.wave, fr = lane & 15, fq = lane >> 4;
    const int hb = blockIdx.x & 7, wslot = blockIdx.x >> 3, nslot = F.G >> 3;
    const bf16* XR = (const bf16*)(F.ws + WS_XR);
    unsigned* PAIR = (unsigned*)(F.ws + WS_LA);
    float* CARP = (float*)(F.ws + WS_CARP); float* CARH = (float*)(F.ws + WS_CARH);
    LAS unsigned char* L = F.lds;
    bf16x8 bx[4], ba[4];
    { const bf16* gx = (const bf16*)(F.ws + WS_GXT) + (size_t)hb * 16384 + (size_t)(16 * wv + fr) * 128 + 8 * fq;
      const bf16* ga = (const bf16*)(F.ws + WS_GAT) + (size_t)hb * 16384 + (size_t)(16 * wv + fr) * 128 + 8 * fq;
#pragma unroll
      for (int ks = 0; ks < 4; ++ks) { bx[ks] = *(const bf16x8*)(gx + 32 * ks); ba[ks] = *(const bf16x8*)(ga + 32 * ks); } }
    const int chl = 16 * wv + fr, ch = 128 * hb + chl;
    const float gxb = F.A->in[I_OD_GX_B][ch], gab = F.A->in[I_OD_GA_B][ch], c8sp = 8.0f * softplusf_(-F.A->in[I_OD_LAMBDA][ch]);
    const int c8 = tid & 15, tg = tid >> 4;
    float cw[4][8], cb[8];
#pragma unroll
    for (int e = 0; e < 8; ++e) { cb[e] = F.A->in[I_OD_CONV_B][128 * hb + 8 * c8 + e];
#pragma unroll
        for (int k = 0; k < 4; ++k) cw[k][e] = F.A->in[I_OD_CONV_W][k * D + 128 * hb + 8 * c8 + e]; }
    v4u pre[3];
    auto issue_raw = [&](int ck) {
#pragma unroll
        for (int j = 0; j < 3; ++j) { const int q = tid + 512 * j; pre[j] = (v4u){0u, 0u, 0u, 0u}; if (q < 67 * 16) { const int rr = q >> 4, cc = q & 15; const int row = chunk_row(ck, rr - 3);
            if (row >= 0) pre[j] = *(const v4u*)(XR + (size_t)row * D + 128 * hb + 8 * cc); } }
    };
    if (wslot < NCHUNK64) issue_raw(wslot);
    __syncthreads();
    for (int ck = wslot; ck < NCHUNK64; ck += nslot) {
#pragma unroll
        for (int j = 0; j < 3; ++j) { const int q = tid + 512 * j; if (q < 67 * 16) { const int rr = q >> 4, cc = q & 15; *(LAS v4u*)(L + LRU_RAW + rr * 272 + cc * 16) = pre[j]; } }
        if (ck + nslot < NCHUNK64) issue_raw(ck + nslot);
        __syncthreads();
#pragma unroll
        for (int j = 0; j < 2; ++j) { const int t = tg + 32 * j; float o[8];
#pragma unroll
            for (int e = 0; e < 8; ++e) o[e] = cb[e];
#pragma unroll
            for (int k = 0; k < 4; ++k) { const v4u v = *(const LAS v4u*)(L + LRU_RAW + (t + k) * 272 + c8 * 16);
                const float x[8] = {bflo(v.x), bfhi(v.x), bflo(v.y), bfhi(v.y), bflo(v.z), bfhi(v.z), bflo(v.w), bfhi(v.w)};
#pragma unroll
                for (int e = 0; e < 8; ++e) o[e] += cw[k][e] * x[e]; }
            *(LAS f32x4*)(L + LRU_XF + t * 528 + c8 * 32) = (f32x4){o[0], o[1], o[2], o[3]}; *(LAS f32x4*)(L + LRU_XF + t * 528 + c8 * 32 + 16) = (f32x4){o[4], o[5], o[6], o[7]};
            v4u w; w.x = cvt_pk_bf16(o[0], o[1]); w.y = cvt_pk_bf16(o[2], o[3]); w.z = cvt_pk_bf16(o[4], o[5]); w.w = cvt_pk_bf16(o[6], o[7]);
            *(LAS v4u*)(L + LRU_XC + t * 272 + c8 * 16) = w; }
        __syncthreads();
#pragma unroll
        for (int mt = 0; mt < 4; ++mt) { f32x4 ax = (f32x4){0.f, 0.f, 0.f, 0.f}, aa = (f32x4){0.f, 0.f, 0.f, 0.f};
#pragma unroll
            for (int ks = 0; ks < 4; ++ks) { const bf16x8 af = *(const LAS bf16x8*)(L + LRU_XC + (16 * mt + fr) * 272 + (32 * ks + 8 * fq) * 2);
                ax = __builtin_amdgcn_mfma_f32_16x16x32_bf16(af, bx[ks], ax, 0, 0, 0); aa = __builtin_amdgcn_mfma_f32_16x16x32_bf16(af, ba[ks], aa, 0, 0, 0); }
#pragma unroll
            for (int r = 0; r < 4; ++r) { const int t = 16 * mt + 4 * fq + r;
                const float gx = sigmoidf_(ax[r] + gxb), ga = sigmoidf_(aa[r] + gab);
                float a = fast_exp(-c8sp * ga); const float om = 1.0f - a * a;
                float u = __builtin_amdgcn_sqrtf(om) * gx * *(const LAS float*)(L + LRU_XF + t * 528 + chl * 4);
                if (ck == MX / 64 && t >= NMETA) { a = 1.f; u = 0.f; }
                *(LAS f32x2*)(L + LRU_LAU + (t * 128 + chl) * 8) = (f32x2){a, u}; } }
        __syncthreads();
        { const int tq = tid >> 7, chn = tid & 127; float hl[16], pl[16]; float h = 0.f, cp = 1.f;
#pragma unroll
            for (int i = 0; i < 16; ++i) { const f32x2 v = *(const LAS f32x2*)(L + LRU_LAU + ((16 * tq + i) * 128 + chn) * 8); cp *= v.x; h = v.x * h + v.y; hl[i] = h; pl[i] = cp; }
            LAS f32x2* qs = (LAS f32x2*)(L + LRU_XC);
            qs[tq * 128 + chn] = (f32x2){cp, h};
            __syncthreads();
            float hin = 0.f, pin = 1.f;
#pragma unroll
            for (int q = 0; q < 3; ++q) if (q < tq) { const f32x2 v = qs[q * 128 + chn]; hin = v.x * hin + v.y; pin *= v.x; }
            const int nval = ck == MX / 64 ? NMETA : 64;
#pragma unroll
            for (int i = 0; i < 16; ++i) { const int t = 16 * tq + i; if (t < nval) { const size_t o = (size_t)chunk_row(ck, t) * D + 128 * hb + chn;
                const unsigned w = cvt_pk_bf16(hl[i] + pl[i] * hin, pl[i] * pin);
                PAIR[o] = w; } }
            if (tq == 3) { CARP[(size_t)ck * D + 128 * hb + chn] = pl[15] * pin; CARH[(size_t)ck * D + 128 * hb + chn] = hl[15] + pl[15] * hin; } }
    }
}
__device__ __forceinline__ void lru_carry_phase(Frame& F) {
    const int gt = blockIdx.x * NTHR + F.tid; if (gt >= NB * D) return;
    const int b = gt >> 10, ch = gt & 1023;
    const float* __restrict__ CARP = (const float*)(F.ws + WS_CARP); const float* __restrict__ CARH = (const float*)(F.ws + WS_CARH); float* __restrict__ CIN = (float*)(F.ws + WS_DT);
    float h = CARH[(size_t)(MX / 64) * D + ch];
    for (int c0 = 0; c0 < 128; c0 += 16) { float p[16], hh[16];
#pragma unroll
        for (int j = 0; j < 16; ++j) { const size_t o = (size_t)(b * 128 + c0 + j) * D + ch; p[j] = CARP[o]; hh[j] = CARH[o]; }
#pragma unroll
        for (int j = 0; j < 16; ++j) { CIN[(size_t)(b * 128 + c0 + j) * D + ch] = h; h = p[j] * h + hh[j]; } }
}
__device__ __forceinline__ void lru_fix_phase(Frame& F) {
    const unsigned* PAIR = (const unsigned*)(F.ws + WS_LA); bf16* U = (bf16*)(F.ws + WS_U); const bf16* G1 = (const bf16*)(F.ws + WS_G1); const float* CIN = (const float*)(F.ws + WS_DT);
    const size_t n = (size_t)MV * 128, stride = (size_t)F.G * NTHR;
    constexpr int UN = 4;
    for (size_t i0 = (size_t)blockIdx.x * NTHR + F.tid; i0 < n; i0 += UN * stride) {
        v4u w0[UN], w1[UN], gv[UN]; f32x4 c0[UN], c1[UN];
#pragma unroll
        for (int u = 0; u < UN; ++u) { const size_t i = i0 + u * stride; w0[u] = w1[u] = gv[u] = (v4u){0u, 0u, 0u, 0u}; c0[u] = c1[u] = (f32x4){0.f, 0.f, 0.f, 0.f};
            if (i < n) { const int row = (int)(i >> 7), c = (int)(i & 127) * 8; const size_t o = (size_t)row * D + c;
                w0[u] = *(const v4u*)(PAIR + o); w1[u] = *(const v4u*)(PAIR + o + 4); gv[u] = *(const v4u*)(G1 + o);
                if (row < MX) { const float* cp = CIN + (size_t)(row >> 6) * D + c; c0[u] = *(const f32x4*)cp; c1[u] = *(const f32x4*)(cp + 4); } } }
#pragma unroll
        for (int u = 0; u < UN; ++u) { const size_t i = i0 + u * stride;
            if (i < n) { const int row = (int)(i >> 7), c = (int)(i & 127) * 8; const size_t o = (size_t)row * D + c; const v4u p = w0[u], q = w1[u], gq = gv[u]; const f32x4 a0 = c0[u], a1 = c1[u];
                float y[8];
                y[0] = (bflo(p.x) + bfhi(p.x) * a0[0]) * bflo(gq.x); y[1] = (bflo(p.y) + bfhi(p.y) * a0[1]) * bfhi(gq.x);
                y[2] = (bflo(p.z) + bfhi(p.z) * a0[2]) * bflo(gq.y); y[3] = (bflo(p.w) + bfhi(p.w) * a0[3]) * bfhi(gq.y);
                y[4] = (bflo(q.x) + bfhi(q.x) * a1[0]) * bflo(gq.z); y[5] = (bflo(q.y) + bfhi(q.y) * a1[1]) * bfhi(gq.z);
                y[6] = (bflo(q.z) + bfhi(q.z) * a1[2]) * bflo(gq.w); y[7] = (bflo(q.w) + bfhi(q.w) * a1[3]) * bfhi(gq.w);
                v4u w; w.x = cvt_pk_bf16(y[0], y[1]); w.y = cvt_pk_bf16(y[2], y[3]); w.z = cvt_pk_bf16(y[4], y[5]); w.w = cvt_pk_bf16(y[6], y[7]);
                *(v4u*)(U + o) = w; } }
    }
}

__device__ __forceinline__ void ln_router_phase(Frame& F, const bf16* S, bf16* H) {
    const int gw = blockIdx.x * NWAVES + F.wave, NGW = F.G * NWAVES, lane = F.lane;
    LAS unsigned* hist = (LAS unsigned*)(F.lds);
    if (F.tid < 8) hist[F.tid] = 0u;
    __syncthreads();
    { int* ROWTOK = (int*)(F.ws + WS_ROWTOK); float* SSLOT = (float*)(F.ws + WS_SSLOT); for (int i = blockIdx.x * NTHR + F.tid; i < MOE_RMAX; i += F.G * NTHR) { ROWTOK[i] = -1; SSLOT[i] = 0.f; } }
    const float* Wr = F.A->in[I_OD_ROUTER];
    float wr[16][8];
#pragma unroll
    for (int j = 0; j < 16; ++j) { const int col = (j >> 3) * 512 + 8 * lane + (j & 7); const f32x4 a = *(const f32x4*)(Wr + (size_t)col * 8), b = *(const f32x4*)(Wr + (size_t)col * 8 + 4);
        wr[j][0] = a[0]; wr[j][1] = a[1]; wr[j][2] = a[2]; wr[j][3] = a[3]; wr[j][4] = b[0]; wr[j][5] = b[1]; wr[j][6] = b[2]; wr[j][7] = b[3]; }
    unsigned* TOPE = (unsigned*)(F.ws + WS_TOPE); float* TOPG = (float*)(F.ws + WS_TOPG);
    const float* g = F.A->in[I_OD_LN1_G]; const float* b = F.A->in[I_OD_LN1_B];
    const LnAffine A = ln_affine(g, b, lane); v4u na = (v4u){0u, 0u, 0u, 0u}, nc = na;
    if (gw < MV) { na = *(const v4u*)(S + (size_t)gw * D + 8 * lane); nc = *(const v4u*)(S + (size_t)gw * D + 512 + 8 * lane); }
    for (int m = gw; m < MV; m += NGW) { const v4u a = na, c = nc; const int mn = m + NGW;
        if (mn < MV) { na = *(const v4u*)(S + (size_t)mn * D + 8 * lane); nc = *(const v4u*)(S + (size_t)mn * D + 512 + 8 * lane); }
        float y[16]; ln_row(a, c, H + (size_t)m * D, A, lane, y);
        if (m < MX) {
            row_to_i8(y, (unsigned char*)(F.ws + WS_H8) + (size_t)m * D, (float*)(F.ws + WS_SROW) + m, lane);
            float lg[8];
#pragma unroll
            for (int e = 0; e < 8; ++e) { float s = 0.f;
#pragma unroll
                for (int j = 0; j < 16; ++j) s += y[j] * wr[j][e];
                lg[e] = wave_sum(s); }
            int e0 = 0; float l0 = lg[0];
#pragma unroll
            for (int e = 1; e < 8; ++e) if (lg[e] > l0) { l0 = lg[e]; e0 = e; }
            int e1 = -1; float l1 = -3.0e38f;
#pragma unroll
            for (int e = 0; e < 8; ++e) if (e != e0 && lg[e] > l1) { l1 = lg[e]; e1 = e; }
            const float g0 = fast_rcp(1.0f + fast_exp(l1 - l0));
            if (lane == 0) { TOPE[m] = (unsigned)e0 | ((unsigned)e1 << 8); TOPG[2 * m] = g0; TOPG[2 * m + 1] = 1.0f - g0; __hip_atomic_fetch_add(hist + e0, 1u, __ATOMIC_RELAXED, __HIP_MEMORY_SCOPE_WORKGROUP); __hip_atomic_fetch_add(hist + e1, 1u, __ATOMIC_RELAXED, __HIP_MEMORY_SCOPE_WORKGROUP); }
        }
    }
    __syncthreads();
    if (F.tid < 8) __hip_atomic_fetch_add((unsigned*)(F.ctl + CW_CNT + F.tid), hist[F.tid], RLX_AGENT);
}
__device__ __forceinline__ int moe_offsets(Frame& F, int (&off)[9]) {
    volatile LAS unsigned* c = F.MISC + 16;
    if (F.MISC[15] != 0u) {
#pragma unroll
        for (int e = 0; e < 9; ++e) off[e] = __builtin_amdgcn_readfirstlane((int)c[e]);
        return off[8] >> 8; }
    off[0] = 0;
#pragma unroll
    for (int e = 0; e < 8; ++e) { const unsigned cn = __builtin_amdgcn_readfirstlane(__hip_atomic_load((unsigned*)(F.ctl + CW_CNT + e), RLX_AGENT)); off[e + 1] = off[e] + (int)((cn + 255u) & ~255u); }
    if (F.tid == 0) {
#pragma unroll
        for (int e = 0; e < 9; ++e) c[e] = (unsigned)off[e];
        F.MISC[15] = 1u; }
    return off[8] >> 8;
}
__device__ __forceinline__ void moe_dispatch_phase(Frame& F) {
    int off[9]; const int ntiles = moe_offsets(F, off);
    LAS unsigned* lcnt = (LAS unsigned*)(F.lds); LAS unsigned* lbase = lcnt + 8;
    LAS unsigned* sp = lcnt + 16;
    const unsigned char* H8 = (const unsigned char*)(F.ws + WS_H8); unsigned char* XG = (unsigned char*)(F.ws + WS_XG); const float* SROW = (const float*)(F.ws + WS_SROW); float* SSLOT = (float*)(F.ws + WS_SSLOT);
    const unsigned* TOPE = (const unsigned*)(F.ws + WS_TOPE); int* ROWTOK = (int*)(F.ws + WS_ROWTOK); unsigned* SLOTP = (unsigned*)(F.ws + WS_SLOTP); int* TILEE = (int*)(F.ws + WS_TILEE);
    if (blockIdx.x == 0) for (int t = F.tid; t < MOE_TMAX; t += NTHR) { int e = 0;
#pragma unroll
        for (int k = 1; k < 8; ++k) if (t * 256 >= off[k]) e = k;
        TILEE[t] = (t < ntiles) ? e : 0; }
    for (int base = blockIdx.x * 256; base < MX; base += F.G * 256) {
        __syncthreads();
        if (F.tid < 8) lcnt[F.tid] = 0u;
        __syncthreads();
        unsigned e0 = 0, e1 = 0, r0 = 0, r1 = 0; const int tok = base + F.tid;
        if (F.tid < 256) { const unsigned te = TOPE[tok]; e0 = te & 255u; e1 = te >> 8; r0 = __hip_atomic_fetch_add(lcnt + e0, 1u, __ATOMIC_RELAXED, __HIP_MEMORY_SCOPE_WORKGROUP); r1 = __hip_atomic_fetch_add(lcnt + e1, 1u, __ATOMIC_RELAXED, __HIP_MEMORY_SCOPE_WORKGROUP); }
        __syncthreads();
        if (F.tid < 8) lbase[F.tid] = __hip_atomic_fetch_add((unsigned*)(F.ctl + CW_CUR + F.tid), lcnt[F.tid], RLX_AGENT);
        __syncthreads();
        if (F.tid < 256) { int o0 = 0, o1 = 0;
#pragma unroll
            for (int k = 0; k < 8; ++k) { if ((int)e0 == k) o0 = off[k]; if ((int)e1 == k) o1 = off[k]; }
            const unsigned p0 = (unsigned)o0 + lbase[e0] + r0, p1 = (unsigned)o1 + lbase[e1] + r1;
            ROWTOK[p0] = tok; ROWTOK[p1] = tok; SLOTP[2 * tok] = p0; SLOTP[2 * tok + 1] = p1;
            const float sc = SROW[tok]; SSLOT[p0] = sc; SSLOT[p1] = sc; sp[2 * F.tid] = p0; sp[2 * F.tid + 1] = p1; }
        __syncthreads();
        for (int i0 = F.wave; i0 < 256; i0 += 4 * NWAVES) { v4u a[4];
#pragma unroll
            for (int k = 0; k < 4; ++k) a[k] = *(const v4u*)(H8 + (size_t)(base + i0 + k * NWAVES) * D + 16 * F.lane);
#pragma unroll
            for (int k = 0; k < 4; ++k) { const int i = i0 + k * NWAVES; const unsigned q0 = sp[2 * i], q1 = sp[2 * i + 1];
                *(v4u*)(XG + (size_t)q0 * D + 16 * F.lane) = a[k]; *(v4u*)(XG + (size_t)q1 * D + 16 * F.lane) = a[k]; } }
    }
}
__device__ __forceinline__ void moe_gather_phase(Frame& F) {
    int off[9]; const int nrows = moe_offsets(F, off) * 256;
    const int* ROWTOK = (const int*)(F.ws + WS_ROWTOK); unsigned char* XG = (unsigned char*)(F.ws + WS_XG); const unsigned char* H8 = (const unsigned char*)(F.ws + WS_H8);
    const float* SROW = (const float*)(F.ws + WS_SROW); float* SSLOT = (float*)(F.ws + WS_SSLOT);
    const int gw = blockIdx.x * NWAVES + F.wave, NGW = F.G * NWAVES, lane = F.lane;
    for (int r = gw; r < nrows; r += NGW) { const int tok = ROWTOK[r]; v4u a = (v4u){0u, 0u, 0u, 0u}; float sc = 0.f;
        if (tok >= 0) { a = *(const v4u*)(H8 + (size_t)tok * D + 16 * lane); sc = SROW[tok]; }
        *(v4u*)(XG + (size_t)r * D + 16 * lane) = a; if (lane == 0) SSLOT[r] = sc; }
}
__device__ __forceinline__ void final_phase(Frame& F, const bf16* H, const float* g, const float* b, float* out) {
    const int gw = blockIdx.x * NWAVES + F.wave, NGW = F.G * NWAVES; const int lane = F.lane;
    const unsigned* SLOTP = (const unsigned*)(F.ws + WS_SLOTP); const float* TOPG = (const float*)(F.ws + WS_TOPG); const bf16* YS = (const bf16*)(F.ws + WS_YSLOT);
    f32x4 gg[4], bb[4];
#pragma unroll
    for (int j = 0; j < 4; ++j) { gg[j] = *(const f32x4*)(g + 256 * j + 4 * lane); bb[j] = *(const f32x4*)(b + 256 * j + 4 * lane); }
    const int nit = (MX - gw + NGW - 1) / NGW;
    int sl0 = 0, sl1 = 0, gt0 = 0, gt1 = 0;
    { const int mt = gw + lane * NGW; if (mt < MX) { sl0 = (int)SLOTP[2 * (size_t)mt]; sl1 = (int)SLOTP[2 * (size_t)mt + 1]; gt0 = __builtin_bit_cast(int, TOPG[2 * (size_t)mt]); gt1 = __builtin_bit_cast(int, TOPG[2 * (size_t)mt + 1]); } }
    v2u aA[4], pA[4], qA[4], aB[4], pB[4], qB[4];
#pragma unroll
    for (int j = 0; j < 4; ++j) { aA[j] = pA[j] = qA[j] = aB[j] = pB[j] = qB[j] = (v2u){0u, 0u}; }
    auto issue = [&](v2u (&ra)[4], v2u (&rp)[4], v2u (&rq)[4], int k) __attribute__((always_inline)) {
        const int m = gw + k * NGW; const unsigned s0 = (unsigned)__builtin_amdgcn_readlane(sl0, k), s1 = (unsigned)__builtin_amdgcn_readlane(sl1, k);
#pragma unroll
        for (int j = 0; j < 4; ++j) { const int co = 256 * j + 4 * lane; ra[j] = *(const v2u*)(H + (size_t)m * D + co); rp[j] = *(const v2u*)(YS + (size_t)s0 * D + co); rq[j] = *(const v2u*)(YS + (size_t)s1 * D + co); } };
    auto consume = [&](const v2u (&ra)[4], const v2u (&rp)[4], const v2u (&rq)[4], int k, float (&v)[16]) __attribute__((always_inline)) {
        const float g0 = __builtin_bit_cast(float, __builtin_amdgcn_readlane(gt0, k)), g1 = __builtin_bit_cast(float, __builtin_amdgcn_readlane(gt1, k));
#pragma unroll
        for (int j = 0; j < 4; ++j) { const v2u a = ra[j], p = rp[j], q = rq[j];
            v[4 * j + 0] = ALPHA * bflo(a.x) + g0 * bflo(p.x) + g1 * bflo(q.x); v[4 * j + 1] = ALPHA * bfhi(a.x) + g0 * bfhi(p.x) + g1 * bfhi(q.x);
            v[4 * j + 2] = ALPHA * bflo(a.y) + g0 * bflo(p.y) + g1 * bflo(q.y); v[4 * j + 3] = ALPHA * bfhi(a.y) + g0 * bfhi(p.y) + g1 * bfhi(q.y); } };
    auto ln_store = [&](float (&v)[16], int k) __attribute__((always_inline)) {
        float s = 0.f;
#pragma unroll
        for (int j = 0; j < 16; ++j) s += v[j];
        const float mean = wave_sum(s) * (1.f / D); float s2 = 0.f;
#pragma unroll
        for (int j = 0; j < 16; ++j) { v[j] -= mean; s2 += v[j] * v[j]; }
        const float rstd = 1.f / sqrtf(wave_sum(s2) * (1.f / D) + LN_EPS);
        float* orow = out + (size_t)(gw + k * NGW) * D;
#pragma unroll
        for (int q = 0; q < 4; ++q) { f32x4 o;
#pragma unroll
            for (int j = 0; j < 4; ++j) o[j] = v[4 * q + j] * rstd * gg[q][j] + bb[q][j];
            *(f32x4*)(orow + 256 * q + 4 * lane) = o; } };
    const int last = nit - 1;
    issue(aA, pA, qA, 0); issue(aB, pB, qB, last < 1 ? last : 1);
    for (int k = 0; k < nit; k += 2) {
        float vA[16], vB[16];
        consume(aA, pA, qA, k, vA); consume(aB, pB, qB, k + 1 < last ? k + 1 : last, vB);
        issue(aA, pA, qA, k + 2 < last ? k + 2 : last); issue(aB, pB, qB, k + 3 < last ? k + 3 : last);
        ln_store(vA, k); ln_store(vB, k + 1 < last ? k + 1 : last);
    }
}

#define WG_BAR() do { asm volatile("s_waitcnt lgkmcnt(0)" ::: "memory"); __builtin_amdgcn_s_barrier(); asm volatile("" ::: "memory"); } while (0)
__device__ __forceinline__ int seq_row(int b, int s) { return s < NMETA ? META0 + s : b * SEQ + s - NMETA; }
#define DPP_ADD(x, ctrl) ((x) + __builtin_bit_cast(float, __builtin_amdgcn_update_dpp(0, __builtin_bit_cast(int, (x)), (ctrl), 0xF, 0xF, false)))
__device__ __forceinline__ float dpp_sum8(float x) {
    x = DPP_ADD(x, 0xB1); x = DPP_ADD(x, 0x4E); x = DPP_ADD(x, 0x141); return x; }
__device__ __forceinline__ float dpp_sum16(float x) {
    x = DPP_ADD(x, 0xB1); x = DPP_ADD(x, 0x4E); x = DPP_ADD(x, 0x141); x = DPP_ADD(x, 0x140); return x; }
__device__ __forceinline__ void rwkv_lin_phase(Frame& F) {
    const bf16* COLS = (const bf16*)(F.ws + WS_COLS); bf16* LIN = (bf16*)(F.dout + DO_LIN); const float* mu = F.A->in[I_EV_SHIFT_MU] + 3072;
    const int n = MV * 32, stride = F.G * NTHR;
    constexpr int U = 4;
    for (int i0 = blockIdx.x * NTHR + F.tid; i0 < n; i0 += U * stride) {
        v4u cvv[U], pvv[U];
#pragma unroll
        for (int u = 0; u < U; ++u) { const int i = i0 + u * stride; cvv[u] = pvv[u] = (v4u){0u, 0u, 0u, 0u};
            if (i < n) { const int row = i >> 5, c = i & 31;
                int prow = row - 1; if (row == META0) prow = -1; else if (row < MX && (row & (SEQ - 1)) == 0) prow = META0 + NMETA - 1;
                cvv[u] = *(const v4u*)(COLS + (size_t)row * COLSW + 3072 + 8 * c); if (prow >= 0) pvv[u] = *(const v4u*)(COLS + (size_t)prow * COLSW + 3072 + 8 * c); } }
#pragma unroll
        for (int u = 0; u < U; ++u) { const int i = i0 + u * stride;
            if (i < n) { const int row = i >> 5, c = i & 31; const v4u cv = cvv[u], pv = pvv[u];
                const float cx[8] = {bflo(cv.x), bfhi(cv.x), bflo(cv.y), bfhi(cv.y), bflo(cv.z), bfhi(cv.z), bflo(cv.w), bfhi(cv.w)}, px[8] = {bflo(pv.x), bfhi(pv.x), bflo(pv.y), bfhi(pv.y), bflo(pv.z), bfhi(pv.z), bflo(pv.w), bfhi(pv.w)};
                const f32x4 m0 = *(const f32x4*)(mu + 8 * c), m1 = *(const f32x4*)(mu + 8 * c + 4); float m[8];
#pragma unroll
                for (int e = 0; e < 8; ++e) { m[e] = cx[e] + (px[e] - cx[e]) * (e < 4 ? m0[e] : m1[e - 4]); if (c < 8) m[e] = 2.0f * sigmoidf_(2.0f * m[e]) - 1.0f; else if (c >= 16) m[e] = sigmoidf_(m[e]); }
                v4u w; w.x = cvt_pk_bf16(m[0], m[1]); w.y = cvt_pk_bf16(m[2], m[3]); w.z = cvt_pk_bf16(m[4], m[5]); w.w = cvt_pk_bf16(m[6], m[7]);
                *(v4u*)(LIN + (size_t)row * 256 + 8 * c) = w; } }
    }
}
constexpr int RC_OP = 0, RC_OPS = 15616, OP_KTT = 0, OP_RTT = 2304, OP_ATT = 4608, OP_KHT = 6912, OP_KT = 9216, OP_AT = 12288, OP_ZL = 15360;
constexpr int RC_CO = 31232, RC_COS = 10752, CO_KTT = 0, CO_RPT = 2304, CO_QPT = 4608, CO_W2 = 5376, CO_GL = 10496;
constexpr int RC_CV = 52736, RC_VB = 73216, RC_GB = 83456, RC_PSB = 93696, RC_PSS = 94976, RC_ZS = 95488, RC_SB = 97536, RC_OB = 106752, RC_SCR = 114944;
constexpr int SCW = 5376, SC_AFT = 0, SC_BF = 1024, SC_PT = 2048, SC_QFT = 2816, SC_KTK = 3840, SC_BTM = 4608;
constexpr int RC_ZERO = RC_SCR + 4 * SCW;
static_assert(RC_ZERO + 16 <= LDSCTL_OFF, "lds");
template <int KS, bool K16> __device__ __forceinline__ f32x4 mm16(const LAS unsigned char* Ap, int lda, const LAS unsigned char* Bp, int ldb, f32x4 acc, int fr, int fq, const LAS unsigned char* zero16 = nullptr) {
#pragma unroll
    for (int ks = 0; ks < KS; ++ks) { const LAS unsigned char* pa = Ap + fr * lda + (32 * ks + 8 * fq) * 2; const LAS unsigned char* pb = Bp + fr * ldb + (32 * ks + 8 * fq) * 2;
        if (K16) { pa = fq < 2 ? pa : zero16; pb = fq < 2 ? pb : zero16; }
        const v4u ar = *(const LAS v4u*)pa, br = *(const LAS v4u*)pb;
        acc = __builtin_amdgcn_mfma_f32_16x16x32_bf16(__builtin_bit_cast(bf16x8, ar), __builtin_bit_cast(bf16x8, br), acc, 0, 0, 0); }
    return acc;
}
__device__ __forceinline__ v2u pk4(float a, float b, float c, float d) { v2u w; w.x = cvt_pk_bf16(a, b); w.y = cvt_pk_bf16(c, d); return w; }
__device__ __forceinline__ void rwkv_unit(Frame& F, int b, int h) {
    const int lane = F.lane, wv = F.wave, fr = lane & 15, fq = lane >> 4;
    LAS unsigned char* L = F.lds;
    const f32x4 z4 = (f32x4){0.f, 0.f, 0.f, 0.f};
    if (wv < 4) {
        const int p = wv;
        for (int q = F.tid; q < 9216 / 4; q += 256) *(LAS unsigned*)(L + RC_SB + q * 4) = 0u;
        f32x4 st[4] = {z4, z4, z4, z4};
        LAS unsigned char* sc = L + RC_SCR + p * SCW; const LAS unsigned char* zr = L + RC_ZERO;
        if (F.tid < 4) *(LAS unsigned*)(L + RC_ZERO + 4 * F.tid) = 0u;
        for (int j = -3; j <= 513; ++j) {
            if (j >= 0 && j <= 512) { const LAS unsigned char* co = L + RC_CO + (j & 1) * RC_COS; LAS unsigned char* cv = L + RC_CV + (j & 3) * 5120 + 16 * p * 80; const LAS unsigned char* sb = L + RC_SB + 16 * p * 144;
                const f32x4 c = mm16<2, false>(co + CO_KTT, 144, sb, 144, z4, fr, fq);
                *(LAS v2u*)(cv + fr * 80 + 4 * fq * 2) = pk4(c[0], c[1], c[2], c[3]);
                f32x4 y = mm16<2, false>(co + CO_RPT, 144, sb, 144, z4, fr, fq);
                y = mm16<1, true>(co + CO_QPT, 48, cv + 32, 80, y, fr, fq, zr);
                LAS float* ob = (LAS float*)(L + RC_OB + (j & 1) * 4096) + 16 * p + fr;
#pragma unroll
                for (int r = 0; r < 4; ++r) ob[(4 * fq + r) * 64] = y[r];
                asm volatile("s_waitcnt lgkmcnt(0)" ::: "memory");
                const LAS float* gl = (const LAS float*)(co + CO_GL);
#pragma unroll
                for (int kt = 0; kt < 4; ++kt) { const f32x4 g4 = *(const LAS f32x4*)(gl + 16 * kt + 4 * fq);
                    st[kt] = mm16<1, false>(co + CO_W2 + 16 * kt * 80, 80, cv, 80, st[kt] * g4, fr, fq);
                    *(LAS v2u*)(L + RC_SB + (16 * p + fr) * 144 + (16 * kt + 4 * fq) * 2) = pk4(st[kt][0], st[kt][1], st[kt][2], st[kt][3]); } }
            const int J = j + 1;
            if (J >= 0 && J <= 512) { const LAS unsigned char* op = L + RC_OP + (J & 1) * RC_OPS; LAS unsigned char* co = L + RC_CO + (J & 1) * RC_COS;
                { bf16x8 fa[2], fh[2], fk[2], fx[2];
#pragma unroll
                  for (int ks = 0; ks < 2; ++ks) { const int o = fr * 144 + (32 * ks + 8 * fq) * 2; fa[ks] = *(const LAS bf16x8*)(op + OP_ATT + o); fh[ks] = *(const LAS bf16x8*)(op + OP_KHT + o); fk[ks] = *(const LAS bf16x8*)(op + OP_KTT + o); fx[ks] = *(const LAS bf16x8*)(op + OP_RTT + o); }
                  f32x4 dA = z4, dB = z4, dP = z4, dQ = z4;
#pragma unroll
                  for (int ks = 0; ks < 2; ++ks) { dA = __builtin_amdgcn_mfma_f32_16x16x32_bf16(fa[ks], fk[ks], dA, 0, 0, 0); dB = __builtin_amdgcn_mfma_f32_16x16x32_bf16(fh[ks], fk[ks], dB, 0, 0, 0); dP = __builtin_amdgcn_mfma_f32_16x16x32_bf16(fa[ks], fx[ks], dP, 0, 0, 0); }
                  if (p == 0) {
#pragma unroll
                      for (int ks = 0; ks < 2; ++ks) dQ = __builtin_amdgcn_mfma_f32_16x16x32_bf16(fh[ks], fx[ks], dQ, 0, 0, 0); }
#pragma unroll
                  for (int r = 0; r < 4; ++r) { const int tau = 4 * fq + r; const bool lt = tau < fr, le = tau <= fr; dB[r] = lt ? dB[r] : 0.f;     dP[r] = le ? dP[r] : 0.f; dQ[r] = le ? dQ[r] : 0.f;
                      *(LAS float*)(sc + SC_BF + (tau * 16 + fr) * 4) = dB[r]; }
                  *(LAS f32x4*)(sc + SC_AFT + (fr * 16 + 4 * fq) * 4) = dA;
                  *(LAS v2u*)(sc + SC_PT + fr * 48 + 4 * fq * 2) = pk4(dP[0], dP[1], dP[2], dP[3]);
                  if (p == 0) *(LAS f32x4*)(sc + SC_QFT + (fr * 16 + 4 * fq) * 4) = dQ; }
                asm volatile("s_waitcnt lgkmcnt(0)" ::: "memory");
                { const int hl = lane & 31; float X[16];
                  if (hl < 16) { const v4u k0 = *(const LAS v4u*)(op + OP_KT + (16 * p + hl) * 48), k1 = *(const LAS v4u*)(op + OP_KT + (16 * p + hl) * 48 + 16);
                      X[0] = bflo(k0.x); X[1] = bfhi(k0.x); X[2] = bflo(k0.y); X[3] = bfhi(k0.y); X[4] = bflo(k0.z); X[5] = bfhi(k0.z); X[6] = bflo(k0.w); X[7] = bfhi(k0.w);
                      X[8] = bflo(k1.x); X[9] = bfhi(k1.x); X[10] = bflo(k1.y); X[11] = bfhi(k1.y); X[12] = bflo(k1.z); X[13] = bfhi(k1.z); X[14] = bflo(k1.w); X[15] = bfhi(k1.w); }
                  else { const LAS f32x4* bp = (const LAS f32x4*)(sc + SC_BF + (hl - 16) * 64); const f32x4 b0 = bp[0], b1 = bp[1], b2 = bp[2], b3 = bp[3];
                      X[0] = b0[0]; X[1] = b0[1]; X[2] = b0[2]; X[3] = b0[3]; X[4] = b1[0]; X[5] = b1[1]; X[6] = b1[2]; X[7] = b1[3]; X[8] = b2[0]; X[9] = b2[1]; X[10] = b2[2]; X[11] = b2[3]; X[12] = b3[0]; X[13] = b3[1]; X[14] = b3[2]; X[15] = b3[3]; }
#define NFMA(acc, x, a) asm("v_fma_f32 %0, -%1, %2, %0" : "+v"(acc) : "v"(x), "v"(a))
#pragma unroll
                  for (int tb = 0; tb < 4; ++tb) {
#pragma unroll
                      for (int t4 = 0; t4 < 4 * tb; t4 += 4) { f32x4 av[4];
#pragma unroll
                          for (int c = 0; c < 4; ++c) av[c] = *(const LAS f32x4*)(sc + SC_AFT + ((4 * tb + c) * 16 + t4) * 4);
#pragma unroll
                          for (int e = 0; e < 4; ++e) {
#pragma unroll
                              for (int c = 0; c < 4; ++c) NFMA(X[4 * tb + c], X[t4 + e], av[c][e]); } }
                      f32x4 dv[4];
#pragma unroll
                      for (int c = 1; c < 4; ++c) dv[c] = *(const LAS f32x4*)(sc + SC_AFT + ((4 * tb + c) * 16 + 4 * tb) * 4);
                      NFMA(X[4 * tb + 1], X[4 * tb], dv[1][0]); NFMA(X[4 * tb + 2], X[4 * tb], dv[2][0]); NFMA(X[4 * tb + 3], X[4 * tb], dv[3][0]);
                      NFMA(X[4 * tb + 2], X[4 * tb + 1], dv[2][1]); NFMA(X[4 * tb + 3], X[4 * tb + 1], dv[3][1]);
                      NFMA(X[4 * tb + 3], X[4 * tb + 2], dv[3][2]); }
                  if (lane < 32) { v4u w0, w1; w0.x = cvt_pk_bf16(X[0], X[1]); w0.y = cvt_pk_bf16(X[2], X[3]); w0.z = cvt_pk_bf16(X[4], X[5]); w0.w = cvt_pk_bf16(X[6], X[7]);
                      w1.x = cvt_pk_bf16(X[8], X[9]); w1.y = cvt_pk_bf16(X[10], X[11]); w1.z = cvt_pk_bf16(X[12], X[13]); w1.w = cvt_pk_bf16(X[14], X[15]);
                      if (hl < 16) { *(LAS v4u*)(sc + SC_KTK + hl * 48) = w0; *(LAS v4u*)(sc + SC_KTK + hl * 48 + 16) = w1;
                          LAS unsigned char* kt = co + CO_KTT + (16 * p + hl) * 2; const unsigned ww[8] = {w0.x, w0.y, w0.z, w0.w, w1.x, w1.y, w1.z, w1.w};
#pragma unroll
                          for (int e = 0; e < 8; ++e) { *(LAS unsigned short*)(kt + (2 * e) * 144) = (unsigned short)(ww[e] & 0xffffu); *(LAS unsigned short*)(kt + (2 * e + 1) * 144) = (unsigned short)(ww[e] >> 16); } }
                      else { *(LAS v4u*)(sc + SC_BTM + (hl - 16) * 48) = w0; *(LAS v4u*)(sc + SC_BTM + (hl - 16) * 48 + 16) = w1; } } }
                asm volatile("s_waitcnt lgkmcnt(0)" ::: "memory");
                { const f32x4 d = mm16<1, true>(sc + SC_KTK, 48, sc + SC_PT, 48, z4, fr, fq, zr);
                  const v2u rt = *(const LAS v2u*)(op + OP_RTT + fr * 144 + (16 * p + 4 * fq) * 2);
                  *(LAS v2u*)(co + CO_RPT + fr * 144 + (16 * p + 4 * fq) * 2) = pk4(bflo(rt.x) - d[0], bfhi(rt.x) - d[1], bflo(rt.y) - d[2], bfhi(rt.y) - d[3]); }
                if (p == 0) { const f32x4 d = mm16<1, true>(sc + SC_BTM, 48, sc + SC_PT, 48, z4, fr, fq, zr);
                  const f32x4 qv = *(const LAS f32x4*)(sc + SC_QFT + (fr * 16 + 4 * fq) * 4);
                  *(LAS v2u*)(co + CO_QPT + fr * 48 + 4 * fq * 2) = pk4(qv[0] - d[0], qv[1] - d[1], qv[2] - d[2], qv[3] - d[3]); }
                { const int k = 16 * p + fr; const float gl = fast_exp(-*(const LAS float*)(op + OP_ZL + k * 4));
                  const f32x4 d = mm16<1, true>(sc + SC_BTM, 48, op + OP_AT + 16 * p * 48, 48, z4, fr, fq, zr);
                  float m2[4];
#pragma unroll
                  for (int r = 0; r < 4; ++r) m2[r] = (bf2f(*(const LAS unsigned short*)(op + OP_KHT + (4 * fq + r) * 144 + k * 2)) - d[r]) * gl;
                  *(LAS v2u*)(co + CO_W2 + k * 80 + (16 + 4 * fq) * 2) = pk4(m2[0], m2[1], m2[2], m2[3]);
                  const v2u at = *(const LAS v2u*)(op + OP_AT + k * 48 + 4 * fq * 2);
                  *(LAS v2u*)(co + CO_W2 + k * 80 + 4 * fq * 2) = pk4(-bflo(at.x) * gl, -bfhi(at.x) * gl, -bflo(at.y) * gl, -bfhi(at.y) * gl);
                  if (fq == 0) *(LAS float*)(co + CO_GL + k * 4) = gl; } }
            WG_BAR();
        }
    } else {
        const int pw = wv - 4, ch = 16 * pw + fr, hj = 64 * h + ch;
        const bf16* COLS = (const bf16*)(F.ws + WS_COLS); const bf16* LIN = (const bf16*)(F.dout + DO_LIN); bf16* Y = (bf16*)(F.ws + WS_Y);
        const float w0 = F.A->in[I_EV_W0][hj], a0 = F.A->in[I_EV_A0][hj], kkc = F.A->in[I_EV_K_K][hj], kac = F.A->in[I_EV_K_A][hj], rkc = F.A->in[I_EV_R_K][hj];
        const float mur = F.A->in[I_EV_SHIFT_MU][hj], muk = F.A->in[I_EV_SHIFT_MU][1024 + hj], muv = F.A->in[I_EV_SHIFT_MU][2048 + hj];
        float lng[4], lnb[4];
#pragma unroll
        for (int r = 0; r < 4; ++r) { lng[r] = F.A->in[I_EV_LNX_G][64 * h + fr + 16 * r]; lnb[r] = F.A->in[I_EV_LNX_B][64 * h + fr + 16 * r]; }
        bf16x8 bw[2], ba[2], bg[4];
        { const bf16* pwp = (const bf16*)(F.ws + WS_WUPT) + (size_t)hj * 64 + 8 * fq; const bf16* pap = (const bf16*)(F.ws + WS_AUPT) + (size_t)hj * 64 + 8 * fq; const bf16* pgp = (const bf16*)(F.ws + WS_GUPT) + (size_t)hj * 128 + 8 * fq;
#pragma unroll
          for (int ks = 0; ks < 2; ++ks) { bw[ks] = *(const bf16x8*)(pwp + 32 * ks); ba[ks] = *(const bf16x8*)(pap + 32 * ks); }
#pragma unroll
          for (int ks = 0; ks < 4; ++ks) bg[ks] = *(const bf16x8*)(pgp + 32 * ks); }
        unsigned cr[4], ck[4], cv[4], qr0 = 0u, qk0 = 0u, qv0 = 0u; bf16x8 lf[8];
        const unsigned xsel = (hj & 1) ? 0x03020c0cu : 0x01000c0cu;
#define XBF(w) __builtin_bit_cast(float, __builtin_amdgcn_perm((w), (w), xsel))
        const __amdgpu_buffer_rsrc_t rsC = __builtin_amdgcn_make_buffer_rsrc((void*)(F.ws + WS_COLS), 0, (int)((size_t)TP * COLSW * 2), 0x00020000);
        const __amdgpu_buffer_rsrc_t rsL = __builtin_amdgcn_make_buffer_rsrc((void*)(F.dout + DO_LIN), 0, (int)((size_t)TP * 256 * 2), 0x00020000);
        const __amdgpu_buffer_rsrc_t rsY = __builtin_amdgcn_make_buffer_rsrc((void*)(F.ws + WS_Y), 0, (int)((size_t)TP * 2048 * 2), 0x00020000);
        const unsigned hjb = (unsigned)(hj * 2) & ~3u;
        auto issue_loads = [&](int J) { const int s0 = 16 * J + 4 * fq;
            const unsigned o0 = (unsigned)seq_row(b, s0) * (COLSW * 2) + hjb;
#pragma unroll
            for (int r = 0; r < 4; ++r) { const unsigned o = o0 + r * (COLSW * 2); cr[r] = __builtin_amdgcn_raw_buffer_load_b32(rsC, o, 0, 0); ck[r] = __builtin_amdgcn_raw_buffer_load_b32(rsC, o + 2048, 0, 0); cv[r] = __builtin_amdgcn_raw_buffer_load_b32(rsC, o, 4096, 0); }
            qr0 = 0u; qk0 = 0u; qv0 = 0u; if (s0 > 0) { const unsigned o = (unsigned)seq_row(b, s0 - 1) * (COLSW * 2) + hjb; qr0 = __builtin_amdgcn_raw_buffer_load_b32(rsC, o, 0, 0); qk0 = __builtin_amdgcn_raw_buffer_load_b32(rsC, o + 2048, 0, 0); qv0 = __builtin_amdgcn_raw_buffer_load_b32(rsC, o, 4096, 0); }
            const unsigned lo = (unsigned)seq_row(b, 16 * J + fr) * 512 + 16 * fq;
#pragma unroll
            for (int ks = 0; ks < 8; ++ks) lf[ks] = __builtin_bit_cast(bf16x8, __builtin_amdgcn_raw_buffer_load_b128(rsL, lo + 64 * ks, 0, 0));
        };
        float kkv_k[4] = {0.f, 0.f, 0.f, 0.f}, a_k[4] = {0.f, 0.f, 0.f, 0.f}, rm_k[4] = {0.f, 0.f, 0.f, 0.f}, k2_k[4] = {0.f, 0.f, 0.f, 0.f}, zc_k[4] = {0.f, 0.f, 0.f, 0.f};
        issue_loads(0);
        for (int j = -3; j <= 513; ++j) {
            if (j + 2 >= 0 && j + 2 <= 512) { const int J = j + 2; LAS unsigned char* op = L + RC_OP + (J & 1) * RC_OPS; const LAS f32x4* ps4 = (const LAS f32x4*)(L + RC_PSS + (J & 1) * 256) + fq; const LAS float* zs = (const LAS float*)(L + RC_ZS + (J & 1) * 1024) + ch * 4;
                float zb = 0.f;
#pragma unroll
                for (int q = 0; q < 3; ++q) if (q < fq) zb += zs[q];
                const f32x4 ss4 = (ps4[0] + ps4[4]) + (ps4[8] + ps4[12]);
                float kt4[4], at4[4]; float eprev = fast_exp(-zb);
#pragma unroll
                for (int r = 0; r < 4; ++r) { const int t = 4 * fq + r; const float kk = kkv_k[r] * rsqrtf(fmaxf(ss4[r], 1e-24f));
                    const float em = fast_exp(-(zb + zc_k[r])), ep = fast_rcp(em);
                    kt4[r] = kk * eprev; at4[r] = kk * a_k[r] * ep; eprev = em;
                    const unsigned u1 = cvt_pk_bf16(kt4[r], rm_k[r] * em), u2 = cvt_pk_bf16(at4[r], k2_k[r] * ep);
                    *(LAS unsigned short*)(op + OP_KTT + t * 144 + ch * 2) = (unsigned short)(u1 & 0xffffu); *(LAS unsigned short*)(op + OP_RTT + t * 144 + ch * 2) = (unsigned short)(u1 >> 16);
                    *(LAS unsigned short*)(op + OP_ATT + t * 144 + ch * 2) = (unsigned short)(u2 & 0xffffu); *(LAS unsigned short*)(op + OP_KHT + t * 144 + ch * 2) = (unsigned short)(u2 >> 16); }
                *(LAS v2u*)(op + OP_KT + ch * 48 + 4 * fq * 2) = pk4(kt4[0], kt4[1], kt4[2], kt4[3]); *(LAS v2u*)(op + OP_AT + ch * 48 + 4 * fq * 2) = pk4(at4[0], at4[1], at4[2], at4[3]);
                if (fq == 3) *(LAS float*)(op + OP_ZL + ch * 4) = zb + zc_k[3]; }
            const bool xv = j + 3 <= 512; const int JX = j + 3;
            f32x4 aw = z4, aa = z4, ag = z4;
            if (xv) {
#pragma unroll
                for (int ks = 0; ks < 2; ++ks) { aw = __builtin_amdgcn_mfma_f32_16x16x32_bf16(lf[ks], bw[ks], aw, 0, 0, 0); aa = __builtin_amdgcn_mfma_f32_16x16x32_bf16(lf[2 + ks], ba[ks], aa, 0, 0, 0); }
#pragma unroll
                for (int ks = 0; ks < 4; ++ks) ag = __builtin_amdgcn_mfma_f32_16x16x32_bf16(lf[4 + ks], bg[ks], ag, 0, 0, 0);
                float vm4[4], zrun = 0.f, sq[4], bo[4]; float pr = XBF(qr0), pk = XBF(qk0), pv = XBF(qv0);
                LAS unsigned char* vbp = L + RC_VB + (JX % 5) * 2048 + (4 * fq * 64 + ch) * 2; LAS unsigned char* gbp = L + RC_GB + (JX % 5) * 2048 + (4 * fq * 64 + ch) * 2;
#pragma unroll
                for (int r = 0; r < 4; ++r) {
                    const float rc = XBF(cr[r]), kc = XBF(ck[r]), vc = XBF(cv[r]);
                    const float rm = rc + (pr - rc) * mur, km = kc + (pk - kc) * muk, vm = vc + (pv - vc) * muv; pr = rc; pk = kc; pv = vc;
                    const float z = 0.6065306597126334f * sigmoidf_(w0 + aw[r]);
                    const float a = sigmoidf_(a0 + aa[r]);
                    const float kkv = km * kkc, k2 = km * (1.0f + (a - 1.0f) * kac);
                    sq[r] = kkv * kkv; bo[r] = rm * k2 * rkc;
                    zrun += z; kkv_k[r] = kkv; a_k[r] = a; rm_k[r] = rm; k2_k[r] = k2; zc_k[r] = zrun; vm4[r] = vm;
                    const unsigned u = cvt_pk_bf16(vm, ag[r]);
                    *(LAS unsigned short*)(vbp + r * 128) = (unsigned short)(u & 0xffffu); *(LAS unsigned short*)(gbp + r * 128) = (unsigned short)(u >> 16); }
                { const bool b3 = (fr & 8) != 0, b2 = (fr & 4) != 0, b1 = (fr & 2) != 0; float k4[4], k2v[2];
#pragma unroll
                  for (int i = 0; i < 4; ++i) { const float keep = b3 ? bo[i] : sq[i], send = b3 ? sq[i] : bo[i]; k4[i] = keep + DPPF(send, 0x140); }
#pragma unroll
                  for (int i = 0; i < 2; ++i) { const float keep = b2 ? k4[2 + i] : k4[i], send = b2 ? k4[i] : k4[2 + i]; k2v[i] = keep + DPPF(send, 0x141); }
                  const float keep = b1 ? k2v[1] : k2v[0], send = b1 ? k2v[0] : k2v[1]; float k1 = keep + DPPF(send, 0x4E); k1 += DPPF(k1, 0xB1);
                  const int idx = fr >> 1; LAS unsigned char* dst = (idx < 4 ? L + RC_PSS + (JX & 1) * 256 : L + RC_PSB + (JX % 5) * 256) + (pw * 16 + 4 * fq + (idx & 3)) * 4;
                  if (!(fr & 1)) *(LAS float*)dst = k1; }
                *(LAS v2u*)(L + RC_CV + (JX & 3) * 5120 + ch * 80 + (16 + 4 * fq) * 2) = pk4(vm4[0], vm4[1], vm4[2], vm4[3]);
                *(LAS float*)(L + RC_ZS + (JX & 1) * 1024 + (ch * 4 + fq) * 4) = zrun;
                if (JX + 1 <= 512) issue_loads(JX + 1); }
            if (j >= 1) { const int J = j - 1, t = 4 * pw + fq; const LAS unsigned char* ob = L + RC_OB + (J & 1) * 4096 + (t * 64 + fr) * 4; const LAS unsigned char* vb = L + RC_VB + (J % 5) * 2048 + (t * 64 + fr) * 2; const LAS unsigned char* gb = L + RC_GB + (J % 5) * 2048 + (t * 64 + fr) * 2;
                float o[4], s = 0.f;
#pragma unroll
                for (int r = 0; r < 4; ++r) { o[r] = *(const LAS float*)(ob + 64 * r); s += o[r]; }
                const float mean = dpp_sum16(s) * (1.0f / 64.0f); float q = 0.f;
#pragma unroll
                for (int r = 0; r < 4; ++r) { o[r] -= mean; q += o[r] * o[r]; }
                const float rstd = rsqrtf(dpp_sum16(q) * (1.0f / 64.0f) + 64e-5f);
                const LAS float* pb = (const LAS float*)(L + RC_PSB + (J % 5) * 256) + t; const float bon = (pb[0] + pb[16]) + (pb[32] + pb[48]);
                const unsigned yo = (unsigned)seq_row(b, 16 * J + t) * 4096 + (1024 + 64 * h + fr) * 2; float y[4];
#pragma unroll
                for (int r = 0; r < 4; ++r) y[r] = (o[r] * rstd * lng[r] + lnb[r] + bon * bf2f(*(const LAS unsigned short*)(vb + 32 * r))) * bf2f(*(const LAS unsigned short*)(gb + 32 * r));
                const unsigned u0 = cvt_pk_bf16(y[0], y[1]), u1 = cvt_pk_bf16(y[2], y[3]);
                __builtin_amdgcn_raw_buffer_store_b16((unsigned short)(u0 & 0xffffu), rsY, yo, 0, 0); __builtin_amdgcn_raw_buffer_store_b16((unsigned short)(u0 >> 16), rsY, yo + 32, 0, 0);
                __builtin_amdgcn_raw_buffer_store_b16((unsigned short)(u1 & 0xffffu), rsY, yo + 64, 0, 0); __builtin_amdgcn_raw_buffer_store_b16((unsigned short)(u1 >> 16), rsY, yo + 96, 0, 0); }
            WG_BAR();
        }
    }
}
__device__ __forceinline__ void ssd_conv_prepass(Frame& F) {
    bf16* XBC = (bf16*)(F.ws + WS_XBC); bf16* SIDE = (bf16*)(F.dout + DO_SIDE);
    const float* CWp = F.A->in[I_EV_CONV_W]; const float* CBp = F.A->in[I_EV_CONV_B];
    const int cgl = F.tid & 63, run = F.tid >> 6;
    for (int u = F.wi; u < 1025 * 3; u += F.wn) { const int id = u / 3, col = 512 * (u % 3) + 8 * cgl;
        v4u raw[11];
#pragma unroll
        for (int i = 0; i < 11; ++i) { const int l = 8 * run - 3 + i; int row = -1;
            if (id < 1024) row = l >= 0 ? 64 * id + l : ((id & 127) == 0 ? META0 + 16 + l : 64 * id + l);
            else if (l >= 48) row = META0 + l - 48;
            raw[i] = (v4u){0u, 0u, 0u, 0u}; if (row >= 0) raw[i] = *(const v4u*)(XBC + (size_t)row * XBCW + col); }
        f32x4 w[4][2], bb[2];
#pragma unroll
        for (int k = 0; k < 4; ++k) { w[k][0] = *(const f32x4*)(CWp + k * XBCW + col); w[k][1] = *(const f32x4*)(CWp + k * XBCW + col + 4); }
        bb[0] = *(const f32x4*)(CBp + col); bb[1] = *(const f32x4*)(CBp + col + 4);
        asm volatile("s_waitcnt vmcnt(0)" ::: "memory");
        __syncthreads();
#pragma unroll
        for (int o = 0; o < 8; ++o) { const int l = 8 * run + o; float y[8] = {bb[0][0], bb[0][1], bb[0][2], bb[0][3], bb[1][0], bb[1][1], bb[1][2], bb[1][3]};
#pragma unroll
            for (int k = 0; k < 4; ++k) { const v4u v = raw[o + k];
                y[0] += w[k][0][0] * bflo(v.x); y[1] += w[k][0][1] * bfhi(v.x); y[2] += w[k][0][2] * bflo(v.y); y[3] += w[k][0][3] * bfhi(v.y);
                y[4] += w[k][1][0] * bflo(v.z); y[5] += w[k][1][1] * bfhi(v.z); y[6] += w[k][1][2] * bflo(v.w); y[7] += w[k][1][3] * bfhi(v.w); }
            v4u q; q.x = cvt_pk_bf16(siluf_(y[0]), siluf_(y[1])); q.y = cvt_pk_bf16(siluf_(y[2]), siluf_(y[3])); q.z = cvt_pk_bf16(siluf_(y[4]), siluf_(y[5])); q.w = cvt_pk_bf16(siluf_(y[6]), siluf_(y[7]));
            if (id < 1024 || l >= 48) { const int row = id < 1024 ? 64 * id + l : META0 + l - 48;
                bf16* dst = l >= 61 ? SIDE + ((size_t)id * 3 + (l - 61)) * XBCW + col : XBC + (size_t)row * XBCW + col;
                *(v4u*)dst = q; } }
    }
    const int gw = F.wi * NWAVES + F.wave, NGW = F.wn * NWAVES, lane = F.lane; const float* DT = (const float*)(F.ws + WS_DT); f32x4* DTX = (f32x4*)(F.dout + DO_DTX);
    for (int wk = gw; wk < 1025 * 16; wk += NGW) { const int id = wk >> 4, h = wk & 15; const float Ah = -__expf(F.A->in[I_EV_A_LOG][h]), dtb = F.A->in[I_EV_DT_BIAS][h];
        int row = -1; if (id < 1024) row = 64 * id + lane; else if (lane >= 48) row = META0 + lane - 48;
        float dt = 0.f; if (row >= 0) dt = softplusf_(DT[(size_t)row * 16 + h] + dtb);
        float acs = dt * Ah;
#pragma unroll
        for (int o = 1; o < 64; o <<= 1) { const float t = __shfl_up(acs, o); if (lane >= o) acs += t; }
        const float tot = __shfl(acs, 63);
        DTX[(size_t)wk * 64 + lane] = (f32x4){dt, acs, fast_exp(tot - acs) * dt, fast_exp(acs)}; }
}
constexpr int SD_XT = 0, SD_BM = 9216, SD_CM = 26624, SD_PS = 44032, SD_BT = 61440, SD_CW = 79872, SD_DT = 86272, SD_ACS = 86528, SD_WGT = 86784, SD_EAC = 87040, SD_HALO = 87296, SD_R1 = 91264;
constexpr int SD_RAW = SD_R1, SD_XWT = SD_R1, SD_MM = SD_R1 + 9216, SD_YT = SD_R1 + 18432, SD_RSTR = 656, SD_HSZ = 3 * 656;
static_assert(SD_R1 + 64 * SD_RSTR <= LDSCTL_OFF && SD_HALO + 2 * SD_HSZ <= SD_R1, "lds");
__device__ __forceinline__ int sd_swz(int row, int col) { return row * 144 + ((((col >> 3) ^ (row >> 3)) & 7) << 4) + (col & 7) * 2; }
__device__ __forceinline__ void ssd_unit(Frame& F, int b, int h) {
    const int tid = F.tid, lane = F.lane, wv = F.wave, fr = lane & 15, fq = lane >> 4, g = h >> 3;
    LAS unsigned char* L = F.lds;
    const bf16* XBC = (const bf16*)(F.ws + WS_XBC); const bf16* Z = (const bf16*)(F.dout + DO_Z); const float* DT = (const float*)(F.ws + WS_DT); bf16* Y = (bf16*)(F.ws + WS_Y);
    const float Dh = F.A->in[I_EV_D_SKIP][h];
    const bf16* SIDE = (const bf16*)(F.dout + DO_SIDE); const f32x4* DTX = (const f32x4*)(F.dout + DO_DTX);
    for (int q = tid; q < 64 * 272 / 4; q += NTHR) *(LAS unsigned*)(L + SD_PS + q * 4) = 0u;
    f32x4 st[4];
#pragma unroll
    for (int pt = 0; pt < 4; ++pt) st[pt] = (f32x4){0.f, 0.f, 0.f, 0.f};
    int it_l[5], it_cg[5], it_col[5];
#pragma unroll
    for (int k = 0; k < 5; ++k) { const int q = tid + 512 * k; it_l[k] = q / 40; it_cg[k] = q % 40; const int cg = it_cg[k]; it_col[k] = cg < 8 ? 64 * h + 8 * cg : cg < 24 ? 1024 + 128 * g + 8 * (cg - 8) : 1280 + 128 * g + 8 * (cg - 24); }
    v4u pf[5]; f32x4 dx = (f32x4){0.f, 0.f, 0.f, 0.f};
    auto issue_s1 = [&](int c) { const int id = c == 0 ? 1024 : b * 128 + c - 1;
#pragma unroll
        for (int k = 0; k < 5; ++k) { const int l = it_l[k]; pf[k] = (v4u){0u, 0u, 0u, 0u};
            if (c > 0 || l >= 48) { const bf16* src = l >= 61 ? SIDE + ((size_t)id * 3 + (l - 61)) * XBCW : XBC + (size_t)(c > 0 ? 64 * id + l : META0 + l - 48) * XBCW; pf[k] = *(const v4u*)(src + it_col[k]); } }
        if (wv == 0) dx = DTX[((size_t)id * 16 + h) * 64 + lane];
    };
    issue_s1(0);
    for (int c = 0; c < 129; ++c) {
#pragma unroll
        for (int k = 0; k < 5; ++k) { const int cg = it_cg[k], l = it_l[k]; const v4u w = pf[k];
            const unsigned short hv[8] = {(unsigned short)(w.x & 0xffff), (unsigned short)(w.x >> 16), (unsigned short)(w.y & 0xffff), (unsigned short)(w.y >> 16), (unsigned short)(w.z & 0xffff), (unsigned short)(w.z >> 16), (unsigned short)(w.w & 0xffff), (unsigned short)(w.w >> 16)};
            if (cg < 8) {
#pragma unroll
                for (int e = 0; e < 8; ++e) *(LAS unsigned short*)(L + SD_XT + sd_swz(8 * cg + e, l)) = hv[e]; }
            else if (cg < 24) { *(LAS v4u*)(L + SD_BM + l * 272 + (cg - 8) * 16) = w;
#pragma unroll
                for (int e = 0; e < 8; ++e) *(LAS unsigned short*)(L + SD_BT + sd_swz(8 * (cg - 8) + e, l)) = hv[e]; }
            else *(LAS v4u*)(L + SD_CM + l * 272 + (cg - 24) * 16) = w; }
        if (wv == 0) { *(LAS float*)(L + SD_DT + lane * 4) = dx[0]; *(LAS float*)(L + SD_ACS + lane * 4) = dx[1]; *(LAS float*)(L + SD_WGT + lane * 4) = dx[2]; *(LAS float*)(L + SD_EAC + lane * 4) = dx[3]; }
        if (c + 1 < 129) issue_s1(c + 1);
        const int el = tid >> 3, ep = (tid & 7) * 8, es = 64 * c - 48 + el; v4u zv = (v4u){0u, 0u, 0u, 0u};
        if (es >= 0) zv = *(const v4u*)(Z + (size_t)seq_row(b, es) * D + 64 * h + ep);
        WG_BAR();
        const float etot = *(const LAS float*)(L + SD_EAC + 63 * 4);
        { const int p = tid >> 3, s0 = (tid & 7) * 8; const v4u v = *(const LAS v4u*)(L + SD_XT + sd_swz(p, s0)); const LAS float* wg = (const LAS float*)(L + SD_WGT) + s0;
          v4u w; w.x = cvt_pk_bf16(bflo(v.x) * wg[0], bfhi(v.x) * wg[1]); w.y = cvt_pk_bf16(bflo(v.y) * wg[2], bfhi(v.y) * wg[3]); w.z = cvt_pk_bf16(bflo(v.z) * wg[4], bfhi(v.z) * wg[5]); w.w = cvt_pk_bf16(bflo(v.w) * wg[6], bfhi(v.w) * wg[7]);
          *(LAS v4u*)(L + SD_XWT + p * 144 + s0 * 2) = w; }
#pragma unroll
        for (int k = 0; k < 2; ++k) { const int id = 2 * wv + k, lt = id >> 2, stl = id & 3; f32x4 acc = (f32x4){0.f, 0.f, 0.f, 0.f};
            if (stl <= lt) {
#pragma unroll
                for (int ks = 0; ks < 4; ++ks) { const bf16x8 af = *(const LAS bf16x8*)(L + SD_CM + (16 * lt + fr) * 272 + (32 * ks + 8 * fq) * 2), bf = *(const LAS bf16x8*)(L + SD_BM + (16 * stl + fr) * 272 + (32 * ks + 8 * fq) * 2);
                    acc = __builtin_amdgcn_mfma_f32_16x16x32_bf16(af, bf, acc, 0, 0, 0); } }
            const int sidx = 16 * stl + fr, l0 = 16 * lt + 4 * fq; const float acs_s = *(const LAS float*)(L + SD_ACS + sidx * 4), dt_s = *(const LAS float*)(L + SD_DT + sidx * 4);
            const f32x4 acl = *(const LAS f32x4*)(L + SD_ACS + l0 * 4); float m[4];
#pragma unroll
            for (int r = 0; r < 4; ++r) m[r] = sidx <= l0 + r ? acc[r] * fast_exp(acl[r] - acs_s) * dt_s : 0.f;
            const unsigned u0 = cvt_pk_bf16(m[0], m[1]), u1 = cvt_pk_bf16(m[2], m[3]); LAS unsigned char* mp = L + SD_MM + l0 * 144 + sidx * 2;
            *(LAS unsigned short*)(mp) = (unsigned short)(u0 & 0xffffu); *(LAS unsigned short*)(mp + 144) = (unsigned short)(u0 >> 16); *(LAS unsigned short*)(mp + 288) = (unsigned short)(u1 & 0xffffu); *(LAS unsigned short*)(mp + 432) = (unsigned short)(u1 >> 16); }
        WG_BAR();
#pragma unroll
        for (int k = 0; k < 2; ++k) { const int id = 2 * wv + k, lt = id >> 2, pt = id & 3; f32x4 yd = (f32x4){0.f, 0.f, 0.f, 0.f}, yo = yd;
#pragma unroll
            for (int ks = 0; ks < 2; ++ks) { const bf16x8 af = *(const LAS bf16x8*)(L + SD_MM + (16 * lt + fr) * 144 + (32 * ks + 8 * fq) * 2), bf = *(const LAS bf16x8*)(L + SD_XT + sd_swz(16 * pt + fr, 32 * ks + 8 * fq));
                yd = __builtin_amdgcn_mfma_f32_16x16x32_bf16(af, bf, yd, 0, 0, 0); }
#pragma unroll
            for (int ks = 0; ks < 4; ++ks) { const bf16x8 af = *(const LAS bf16x8*)(L + SD_CM + (16 * lt + fr) * 272 + (32 * ks + 8 * fq) * 2), bf = *(const LAS bf16x8*)(L + SD_PS + (16 * pt + fr) * 272 + (32 * ks + 8 * fq) * 2);
                yo = __builtin_amdgcn_mfma_f32_16x16x32_bf16(af, bf, yo, 0, 0, 0); }
            const int p = 16 * pt + fr, l0 = 16 * lt + 4 * fq;
            const v2u xw = *(const LAS v2u*)(L + SD_XT + sd_swz(p, l0)); const f32x4 ea = *(const LAS f32x4*)(L + SD_EAC + l0 * 4);
            const float y0 = yd[0] + ea[0] * yo[0] + Dh * bflo(xw.x), y1 = yd[1] + ea[1] * yo[1] + Dh * bfhi(xw.x), y2 = yd[2] + ea[2] * yo[2] + Dh * bflo(xw.y), y3 = yd[3] + ea[3] * yo[3] + Dh * bfhi(xw.y);
            const unsigned u0 = cvt_pk_bf16(y0, y1), u1 = cvt_pk_bf16(y2, y3); LAS unsigned char* yp = L + SD_YT + l0 * 144 + p * 2;
            *(LAS unsigned short*)(yp) = (unsigned short)(u0 & 0xffffu); *(LAS unsigned short*)(yp + 144) = (unsigned short)(u0 >> 16); *(LAS unsigned short*)(yp + 288) = (unsigned short)(u1 & 0xffffu); *(LAS unsigned short*)(yp + 432) = (unsigned short)(u1 >> 16); }
#pragma unroll
        for (int pt = 0; pt < 4; ++pt) { f32x4 acc = st[pt] * etot;
#pragma unroll
            for (int ks = 0; ks < 2; ++ks) { const bf16x8 af = *(const LAS bf16x8*)(L + SD_BT + sd_swz(16 * wv + fr, 32 * ks + 8 * fq)), bf = *(const LAS bf16x8*)(L + SD_XWT + (16 * pt + fr) * 144 + (32 * ks + 8 * fq) * 2);
                acc = __builtin_amdgcn_mfma_f32_16x16x32_bf16(af, bf, acc, 0, 0, 0); }
            st[pt] = acc; }
        WG_BAR();
#pragma unroll
        for (int pt = 0; pt < 4; ++pt) { v2u w; w.x = cvt_pk_bf16(st[pt][0], st[pt][1]); w.y = cvt_pk_bf16(st[pt][2], st[pt][3]);
            *(LAS v2u*)(L + SD_PS + (16 * pt + fr) * 272 + (16 * wv + 4 * fq) * 2) = w; }
        if (es >= 0) { const v4u yv = *(const LAS v4u*)(L + SD_YT + el * 144 + ep * 2);
            v4u w; w.x = cvt_pk_bf16(bflo(yv.x) * siluf_(bflo(zv.x)), bfhi(yv.x) * siluf_(bfhi(zv.x))); w.y = cvt_pk_bf16(bflo(yv.y) * siluf_(bflo(zv.y)), bfhi(yv.y) * siluf_(bfhi(zv.y)));
            w.z = cvt_pk_bf16(bflo(yv.z) * siluf_(bflo(zv.z)), bfhi(yv.z) * siluf_(bfhi(zv.z))); w.w = cvt_pk_bf16(bflo(yv.w) * siluf_(bflo(zv.w)), bfhi(yv.w) * siluf_(bfhi(zv.w)));
            *(v4u*)(Y + (size_t)seq_row(b, es) * 2048 + 64 * h + ep) = w; }
    }
}
__device__ __forceinline__ void ssd_norm_phase(Frame& F) {
    const int gw = F.wi * NWAVES + F.wave, NGW = F.wn * NWAVES, lane = F.lane; bf16* Y = (bf16*)(F.ws + WS_Y); const float* nw = F.A->in[I_EV_SSM_NORM];
    v4u nx[2] = {(v4u){0u, 0u, 0u, 0u}, (v4u){0u, 0u, 0u, 0u}};
    if (gw < MV) { nx[0] = *(const v4u*)(Y + (size_t)gw * 2048 + 8 * lane); nx[1] = *(const v4u*)(Y + (size_t)gw * 2048 + 512 + 8 * lane); }
    for (int m = gw; m < MV; m += NGW) { const v4u cur[2] = {nx[0], nx[1]}; const int mn = m + NGW;
        if (mn < MV) { nx[0] = *(const v4u*)(Y + (size_t)mn * 2048 + 8 * lane); nx[1] = *(const v4u*)(Y + (size_t)mn * 2048 + 512 + 8 * lane); }
#pragma unroll
        for (int hlf = 0; hlf < 2; ++hlf) { bf16* p = Y + (size_t)m * 2048 + hlf * 512 + 8 * lane; const v4u a = cur[hlf];
            float v[8] = {bflo(a.x), bfhi(a.x), bflo(a.y), bfhi(a.y), bflo(a.z), bfhi(a.z), bflo(a.w), bfhi(a.w)}; float ss = 0.f;
#pragma unroll
            for (int e = 0; e < 8; ++e) ss += v[e] * v[e];
            const float sc = rsqrtf(wave_sum(ss) * (1.0f / 512.0f) + LN_EPS); const f32x4 n0 = *(const f32x4*)(nw + hlf * 512 + 8 * lane), n1 = *(const f32x4*)(nw + hlf * 512 + 8 * lane + 4);
            v4u w; w.x = cvt_pk_bf16(v[0] * sc * n0[0], v[1] * sc * n0[1]); w.y = cvt_pk_bf16(v[2] * sc * n0[2], v[3] * sc * n0[3]); w.z = cvt_pk_bf16(v[4] * sc * n1[0], v[5] * sc * n1[1]); w.w = cvt_pk_bf16(v[6] * sc * n1[2], v[7] * sc * n1[3]);
            *(v4u*)p = w; }
    }
}
__device__ __forceinline__ void group_barrier(unsigned* cnt, unsigned members, unsigned* bar) {
    asm volatile("s_waitcnt vmcnt(0)" ::: "memory");
    __syncthreads();
    if (threadIdx.x == 0) {
        __builtin_amdgcn_fence(__ATOMIC_RELEASE, "agent");
        asm volatile("s_waitcnt vmcnt(0)" ::: "memory");
        (void)xb_add(cnt, 1u);
        XB_SPIN(xb_ld(cnt) < members, bar);
        __builtin_amdgcn_fence(__ATOMIC_ACQUIRE, "agent");
        asm volatile("s_waitcnt vmcnt(0)" ::: "memory");
    }
    __syncthreads();
}
__device__ __forceinline__ void group_arrive(unsigned* cnt) {
    asm volatile("s_waitcnt vmcnt(0)" ::: "memory");
    __syncthreads();
    if (threadIdx.x == 0) { __builtin_amdgcn_fence(__ATOMIC_RELEASE, "agent"); asm volatile("s_waitcnt vmcnt(0)" ::: "memory"); (void)xb_add(cnt, 1u); }
}
__device__ __forceinline__ void group_wait(unsigned* cnt, unsigned members, unsigned* bar) {
    if (threadIdx.x == 0) { XB_SPIN(xb_ld(cnt) < members, bar); __builtin_amdgcn_fence(__ATOMIC_ACQUIRE, "agent"); asm volatile("s_waitcnt vmcnt(0)" ::: "memory"); }
    __syncthreads();
}
__device__ __forceinline__ void mixers_phase(Frame& F, unsigned* bar) {
    const int u = blockIdx.x;
    if (u < 128) rwkv_unit(F, u >> 4, u & 15);
    else if (u < 256) {
        F.wi = u - 128; F.wn = 128; ssd_conv_prepass(F); F.wi = blockIdx.x; F.wn = F.G;
        group_barrier((unsigned*)(F.ctl + CW_GRP), 128u, bar);
        ssd_unit(F, (u - 128) >> 4, (u - 128) & 15);
        __syncthreads();
        F.wi = u - 128; F.wn = 128; late_weights(F); expert_amax_phase<false>(F);
        group_barrier((unsigned*)(F.ctl + CW_GRP + 1), 128u, bar);
        ssd_norm_phase(F);
        convert_experts(F); convert_wgu8(F); F.wi = blockIdx.x; F.wn = F.G; }
}


template <bool DUAL, int KS  , class EpiS>
__device__ __forceinline__ void skinny_rows(Frame& F, const bf16* A16, int lda, int K, const bf16* Bt, int ntiles, const EpiS& E) {
    const int fr = F.lane & 15, fq = F.lane >> 4; LAS f32x4* part = (LAS f32x4*)F.lds;
    for (int tl = blockIdx.x; tl < ntiles; tl += F.G) {
        const int br0 = E.brow(tl), kw = F.wave * 32 * KS;
        const bf16* ap = A16 + (size_t)fr * lda + kw + 8 * fq; const bf16* bp = Bt + (size_t)(br0 + fr) * K + kw + 8 * fq; const bf16* bp2 = bp + (size_t)128 * K;
        bf16x8 a[KS], b[KS], b2[DUAL ? KS : 1];
#pragma unroll
        for (int s = 0; s < KS; ++s) { a[s] = *(const bf16x8*)(ap + 32 * s); b[s] = *(const bf16x8*)(bp + 32 * s); if (DUAL) b2[s] = *(const bf16x8*)(bp2 + 32 * s); }
        f32x4 acc = (f32x4){0.f, 0.f, 0.f, 0.f}, acc2 = acc;
#pragma unroll
        for (int s = 0; s < KS; ++s) { acc = __builtin_amdgcn_mfma_f32_16x16x32_bf16(a[s], b[s], acc, 0, 0, 0); if (DUAL) acc2 = __builtin_amdgcn_mfma_f32_16x16x32_bf16(a[s], b2[s], acc2, 0, 0, 0); }
        __syncthreads();
        part[F.wave * 64 + F.lane] = acc; if (DUAL) part[512 + F.wave * 64 + F.lane] = acc2;
        __syncthreads();
        if (F.wave == 0) {
            acc = part[F.lane]; if (DUAL) acc2 = part[512 + F.lane];
#pragma unroll
            for (int w = 1; w < 8; ++w) { acc += part[w * 64 + F.lane]; if (DUAL) acc2 += part[512 + w * 64 + F.lane]; }
            E(tl, acc, acc2, fr, fq);
        }
    }
    __syncthreads();
}
struct SkIn0 { bf16* Z; bf16* XBC; bf16* COLS; float* DT;
    __device__ __forceinline__ int brow(int tl) const { return 16 * tl; }
    __device__ __forceinline__ void operator()(int tl, const f32x4& acc, const f32x4&, int fr, int fq) const { const int c = 16 * tl + fr;
#pragma unroll
        for (int r = 0; r < 4; ++r) { const size_t row = META0 + 4 * fq + r;
            if (c < 1024) Z[row * 1024 + c] = (bf16)f2bf(acc[r]); else if (c < 2560) XBC[row * XBCW + c - 1024] = (bf16)f2bf(acc[r]); else if (c < 5888) COLS[row * COLSW + c - 2560] = (bf16)f2bf(acc[r]); else DT[row * 16 + c - 5888] = acc[r]; } } };
struct SkResid { const bf16* Hres; bf16* S;
    __device__ __forceinline__ int brow(int tl) const { return 16 * tl; }
    __device__ __forceinline__ void operator()(int tl, const f32x4& acc, const f32x4&, int fr, int fq) const { const int c = 16 * tl + fr;
#pragma unroll
        for (int r = 0; r < 4; ++r) { const size_t o = (size_t)(META0 + 4 * fq + r) * 1024 + c; S[o] = (bf16)f2bf(ALPHA * bf2f(Hres[o]) + acc[r]); } } };
struct SkSwiglu { bf16* ACT;
    __device__ __forceinline__ int brow(int tl) const { const int j0 = 16 * tl; return 256 * (j0 >> 7) + (j0 & 127); }
    __device__ __forceinline__ void operator()(int tl, const f32x4& g, const f32x4& u, int fr, int fq) const {
#pragma unroll
        for (int r = 0; r < 4; ++r) ACT[(size_t)(META0 + 4 * fq + r) * DFF + 16 * tl + fr] = (bf16)f2bf(siluf_(g[r]) * u[r]); } };
struct SkIn1 { bf16* G1; bf16* XR;
    __device__ __forceinline__ int brow(int tl) const { return 16 * tl; }
    __device__ __forceinline__ void operator()(int tl, const f32x4& acc, const f32x4&, int fr, int fq) const { const int c = 16 * tl + fr;
#pragma unroll
        for (int r = 0; r < 4; ++r) { const size_t row = META0 + 4 * fq + r; if (c < 1024) G1[row * 1024 + c] = (bf16)f2bf(gelu_tanh(acc[r])); else XR[row * 1024 + c - 1024] = (bf16)f2bf(acc[r]); } } };

template <int SLEEP  > __device__ __forceinline__ void stagger(Frame&) {
    const int r = (blockIdx.x >> 3) & 31;
    if (false) for (int i = 0; i < r; ++i) __builtin_amdgcn_s_sleep(SLEEP);
}

constexpr int N_PHASES = 24;
__global__ void __launch_bounds__(NTHR, 2) mega_fwd(Args args) {
    extern __shared__ __attribute__((aligned(16))) unsigned char lds[];
    Frame F;
    F.lds = (LAS unsigned char*)lds;
    F.MISC = (volatile LAS unsigned*)(F.lds + MISC_OFF);
    F.tid = threadIdx.x; F.lane = F.tid & 63; F.wave = __builtin_amdgcn_readfirstlane(F.tid >> 6); F.G = gridDim.x; F.wi = blockIdx.x; F.wn = gridDim.x;
    F.ws = args.ws; F.dout = (unsigned char*)args.out; F.ctl = (gu32*)(args.ws + WS_CTL);
    F.A = &args;
    for (int u = F.tid; u < (LDS_BYTES - LDSCTL_OFF) / 4; u += NTHR) ((LAS unsigned*)(F.lds + LDSCTL_OFF))[u] = 0u;
    __syncthreads();
    const int lo = args.ph_lo, hi = args.ph_hi;
    const bool multi = (hi - lo) > 1;
    XcdBarrier bar; bar.bar = (unsigned*)(F.ctl + CW_BAR); bar.x = 0; bar.st = nullptr;
    if (multi) bar = xcd_barrier_post((unsigned*)(F.ctl + CW_BAR), F.MISC + 8);
#define IN(k) (lo <= (k) && (k) < hi)
#define SEAM(k) do { if (IN(k) && IN((k) + 1)) xcd_barrier(bar); } while (0)
    bf16* H = (bf16*)(F.ws + WS_H);
    bf16* S = (bf16*)(F.dout + DO_Z);
    bf16* Y = (bf16*)(F.ws + WS_Y);

    if (IN(0)) { expert_amax_phase<true>(F); group_arrive((unsigned*)(F.ctl + CW_GRP + 2)); p0_prologue(F); group_wait((unsigned*)(F.ctl + CW_GRP + 2), (unsigned)F.G, bar.bar); convert_win8(F); } SEAM(0);
    if (IN(1)) {
        stagger<16>(F);
        pg8::Gemm g{(const bf16*)(F.ws + WS_H80), (const bf16*)(F.dout + DO_WIN8), D / 2, D / 2}; pg8::StaticOrder so; so.init(MX / 256, IN0_N / 256, F.G, (int)blockIdx.x);
        EpiIn0I8 E{(bf16*)(F.dout + DO_Z), (bf16*)(F.ws + WS_XBC), (bf16*)(F.ws + WS_COLS), (float*)(F.ws + WS_DT), (const float*)(F.ws + WS_SROW), (const unsigned*)(F.ctl + CW_EAMAX + 9), {}};
        pg8::gemm_phase<EpiIn0I8, pg8::StaticOrder, true, true, true>(F.lds, g, so, E);
        skinny_rows<false, 4>(F, H + (size_t)META0 * D, D, D, (const bf16*)(F.dout + DO_WINT), 369, SkIn0{E.Z, E.XBC, E.COLS, E.DT});
    } SEAM(1);
    if (IN(2)) { rwkv_lin_phase(F); xcd_barrier(bar); mixers_phase(F, bar.bar); } SEAM(2);
    if (IN(4)) {
        pg8::Gemm g{Y, (const bf16*)(F.dout + DO_WOUTT), 2048, 2048}; pg8::StaticOrder so; so.init(MX / 256, 4, F.G, (int)blockIdx.x);
        EpiResid E{H, S};
        pg8::gemm_phase<EpiResid, pg8::StaticOrder, true, true>(F.lds, g, so, E);
        skinny_rows<false, 8>(F, Y + (size_t)META0 * 2048, 2048, 2048, (const bf16*)(F.dout + DO_WOUTT), 64, SkResid{H, S});
    } SEAM(4);
    if (IN(5)) { ln_phase<true>(F, S, H, F.A->in[I_EV_LN1_G], F.A->in[I_EV_LN1_B]); } SEAM(5);
    if (IN(6)) {
        stagger<16>(F);
        pg8::Gemm g{(const bf16*)(F.ws + WS_H80), (const bf16*)(F.dout + DO_WGU8), D / 2, D / 2}; pg8::StaticOrder so; so.init(MX / 256, 2 * DFF / 256, F.G, (int)blockIdx.x);
        EpiSwigluI8<true> E{(void*)(F.ws + WS_ACT0), 0, (const float*)(F.ws + WS_SROW), nullptr, (const unsigned*)(F.ctl + CW_EAMAX + 8), {}};
        pg8::gemm_phase<EpiSwigluI8<true>, pg8::StaticOrder, true, true, true>(F.lds, g, so, E);
        skinny_rows<true, 4>(F, H + (size_t)META0 * D, D, D, (const bf16*)(F.dout + DO_WGUT), DFF / 16, SkSwiglu{(bf16*)(F.ws + WS_ACT0)});
    } SEAM(6);
    if (IN(7)) {
        pg8::Gemm g{(const bf16*)(F.ws + WS_ACT0), (const bf16*)(F.dout + DO_WDN8), DFF / 2, DFF / 2}; pg8::StaticOrder so; so.init(MX / 256, 4, F.G, (int)blockIdx.x);
        EpiResidI8 E{H, S, (const unsigned*)(F.ctl + CW_EAMAX + 10), 0.f};
        pg8::gemm_phase<EpiResidI8, pg8::StaticOrder, true, true, true>(F.lds, g, so, E);
        skinny_rows<false, 11>(F, (const bf16*)(F.ws + WS_ACT0) + (size_t)META0 * DFF, DFF, DFF, (const bf16*)(F.dout + DO_WDNT), 64, SkResid{H, S});
    } SEAM(7);
    if (IN(8)) { ln_phase<true>(F, S, H, F.A->in[I_EV_LN2_G], F.A->in[I_EV_LN2_B], WS_H81); } SEAM(8);
    if (IN(9)) {
        pg8::Gemm g{(const bf16*)(F.ws + WS_H81), (const bf16*)(F.dout + DO_WIN18), D / 2, D / 2}; pg8::StaticOrder so; so.init(MX / 256, 8, F.G, (int)blockIdx.x);
        EpiIn1I8 E{(bf16*)(F.ws + WS_G1), (bf16*)(F.ws + WS_XR), (const float*)(F.ws + WS_SROW), (const unsigned*)(F.ctl + CW_EAMAX + 11), {}};
        pg8::gemm_phase<EpiIn1I8, pg8::StaticOrder, true, true, true>(F.lds, g, so, E);
        skinny_rows<false, 4>(F, H + (size_t)META0 * D, D, D, (const bf16*)(F.ws + WS_WIN1T), 128, SkIn1{E.G1, E.XR});
    } SEAM(9);
    if (IN(10)) { lru_gates_phase(F); } SEAM(10);
    if (IN(11)) { lru_carry_phase(F); } SEAM(11);
    if (IN(12)) { lru_fix_phase(F); } SEAM(12);
    if (IN(13)) {
        pg8::Gemm g{(const bf16*)(F.ws + WS_U), (const bf16*)(F.ws + WS_WOUT1T), D, D}; pg8::StaticOrder so; so.init(MX / 256, 4, F.G, (int)blockIdx.x);
        EpiResid E{H, S};
        pg8::gemm_phase<EpiResid, pg8::StaticOrder, true, true>(F.lds, g, so, E);
        skinny_rows<false, 4>(F, (const bf16*)(F.ws + WS_U) + (size_t)META0 * D, D, D, (const bf16*)(F.ws + WS_WOUT1T), 64, SkResid{H, S});
    } SEAM(13);
    if (IN(14)) { ln_router_phase(F, S, H); } SEAM(14);
    if (IN(15)) { moe_dispatch_phase(F); } SEAM(15);
#define MOE_CHUNK_PHASES(q, pa, pb) \
    if (IN(pa)) { stagger<14>(F); int off[9]; const int ntiles = moe_offsets(F, off); const int t0 = (q) * 256; int nM = ntiles - t0; nM = nM < 0 ? 0 : (((q) == 0 && nM > 256) ? 256 : nM);     \
        pg8::Gemm g{(const bf16*)(F.ws + WS_XG), (const bf16*)(F.ws + WS_WEGU), D / 2, D / 2}; MoeOrder mo; _Pragma("unroll") for (int k = 0; k < 7; ++k) mo.toff[k] = off[k + 1] >> 8; mo.t0 = t0; mo.nbt = 2 * DFF / 256; mo.so.init(nM, 2 * DFF / 256, F.G, (int)blockIdx.x); \
        EpiSwigluI8<true> E{(void*)(F.ws + WS_ACTM), t0 * 256, (const float*)(F.ws + WS_SSLOT), (const int*)(F.ws + WS_TILEE), (const unsigned*)(F.ctl + CW_EAMAX), {}}; \
        pg8::gemm_phase<EpiSwigluI8<true>, MoeOrder, true, true, true>(F.lds, g, mo, E); } SEAM(pa); \
    if (IN(pb)) { int off[9]; const int ntiles = moe_offsets(F, off); const int t0 = (q) * 256; int nM = ntiles - t0; nM = nM < 0 ? 0 : (((q) == 0 && nM > 256) ? 256 : nM);     \
        pg8::Gemm g{(const bf16*)((const unsigned char*)(F.ws + WS_ACTM) - (size_t)t0 * 256 * DFF), (const bf16*)(F.ws + WS_WEDN), DFF / 2, DFF / 2}; MoeOrder mo; _Pragma("unroll") for (int k = 0; k < 7; ++k) mo.toff[k] = off[k + 1] >> 8; mo.t0 = t0; mo.nbt = 4; mo.so.init(nM, 4, F.G, (int)blockIdx.x); \
        EpiPlainI8 E{(bf16*)(F.ws + WS_YSLOT), (const int*)(F.ws + WS_TILEE), (const unsigned*)(F.ctl + CW_EAMAX + 16), 0.f}; \
        pg8::gemm_phase<EpiPlainI8, MoeOrder, true, true, true>(F.lds, g, mo, E); } SEAM(pb);
    MOE_CHUNK_PHASES(0, 17, 18)
    MOE_CHUNK_PHASES(1, 19, 20)
    if (IN(23)) { final_phase(F, H, F.A->in[I_OD_LN2_G], F.A->in[I_OD_LN2_B], args.out); }
#undef IN
#undef SEAM
}

#ifndef MK_PER_PHASE
#define MK_PER_PHASE 0
#endif
extern "C" void kernel_launch(void* const* d_in, const int* in_sizes, int n_in, void* d_out, int out_size, void* d_ws, size_t ws_size, hipStream_t stream) {
    static int grid = 0;
    if (grid == 0) {
        if (n_in != 43 || in_sizes[0] != MX * D || out_size != MX * D || ws_size < WS_END) { fprintf(stderr, "kernel_launch: unexpected shapes: n_in %d in0 %d out %d ws %zu\n", n_in, n_in > 0 ? in_sizes[0] : -1, out_size, ws_size); grid = -1; return; }
        int dev = 0, cus = 0, per_cu = 0;
        if (hipGetDevice(&dev) != hipSuccess || hipDeviceGetAttribute(&cus, hipDeviceAttributeMultiprocessorCount, dev) != hipSuccess) { grid = -1; return; }
        if (hipFuncSetAttribute((const void*)mega_fwd, hipFuncAttributeMaxDynamicSharedMemorySize, LDS_BYTES) != hipSuccess) { fprintf(stderr, "kernel_launch: hipFuncSetAttribute failed\n"); grid = -1; return; }
        if (hipOccupancyMaxActiveBlocksPerMultiprocessor(&per_cu, (const void*)mega_fwd, NTHR, LDS_BYTES) != hipSuccess || per_cu < 1) { fprintf(stderr, "kernel_launch: occupancy query says %d\n", per_cu); }
        (void)hipGetLastError();
        grid = cus;
    }
    if (grid < 0) return;
    if (hipMemsetAsync((char*)d_ws + WS_CTL, 0, CTL_ZERO_BYTES, stream) != hipSuccess) return;
    Args a{};
    for (int i = 0; i < 43; ++i) a.in[i] = (const float*)d_in[i];
    a.out = (float*)d_out; a.ws = (unsigned char*)d_ws;
#if MK_PER_PHASE
    for (int p = 0; p < N_PHASES; ++p) { a.ph_lo = p; a.ph_hi = p + 1; hipLaunchKernelGGL(mega_fwd, dim3(grid), dim3(NTHR), LDS_BYTES, stream, a); }
#else
    a.ph_lo = 0; a.ph_hi = N_PHASES;
    hipLaunchKernelGGL(mega_fwd, dim3(grid), dim3(NTHR), LDS_BYTES, stream, a);
#endif
}
```
